# Optimizing an MI355X kernel written in HIP

```python
import jax, jax.numpy as jnp
from jax import lax
import numpy as np

D_MODEL = 1024
BATCH = 32
SEQ = 2048
DEPTH = 1
DEC_BATCH = 16
DEC_SEQ = 64
PAST_LEN = 1024

CHUNK = 64
N_META = 16
GLA_HEADS = 4
GLA_DK = D_MODEL // 2
GLA_DV = D_MODEL
GLA_DK_HEAD = GLA_DK // GLA_HEADS
GLA_DV_HEAD = GLA_DV // GLA_HEADS
GATE_RANK = 16
GATE_TAU = 16.0
POOL_WIDTH = D_MODEL // 2
POOL_WINDOWS = (2, 4, 8, 16)
POOL_GROUPS = len(POOL_WINDOWS)
POOL_GROUP = POOL_WIDTH // POOL_GROUPS
POOL_OUT_GROUP = D_MODEL // POOL_GROUPS
POOL_BUF = max(POOL_WINDOWS) - 1
D_FF = -(-8 * D_MODEL // (3 * 256)) * 256
IN_SPLITS = (GLA_DK, GLA_DK, GLA_DV, GLA_DV, GATE_RANK, POOL_WIDTH, D_MODEL, D_MODEL)
D_IN = sum(IN_SPLITS)
EPS = 1e-6

kernel_name = 'gla_pool_gated_hybrid_stream_step'


def _rmsnorm(x, g):
    xf = x.astype(jnp.float32)
    y = xf * lax.rsqrt(jnp.mean(xf * xf, axis=-1, keepdims=True) + EPS)
    return (y * g.astype(jnp.float32)).astype(x.dtype)


def _gla_scan(q, k, v, g, S0):
    C = q.shape[2]
    causal = jnp.tril(jnp.ones((C, C), dtype=bool))

    def step(S, inp):
        qc, kc, vc, gc = inp
        b = jnp.cumsum(gc, axis=1)
        o_inter = jnp.einsum('bthk,bhkv->bthv', qc * jnp.exp(b), S)
        diff = b[:, :, None] - b[:, None]
        decay = jnp.exp(jnp.where(causal[None, :, :, None, None], diff, -jnp.inf))
        attn = jnp.einsum('bthk,bshk,btshk->bhts', qc, kc, decay)
        o_intra = jnp.einsum('bhts,bshv->bthv', attn, vc)
        b_last = b[:, -1]
        k_dec = kc * jnp.exp(b_last[:, None] - b)
        S_new = jnp.exp(b_last)[..., None] * S + jnp.einsum('bshk,bshv->bhkv', k_dec, vc)
        return S_new, o_inter + o_intra

    S, o = lax.scan(step, S0, (q, k, v, g))
    return o, S


def _gla(q, k, v, log_a, S0, front_pad):
    B, L = q.shape[0], q.shape[1]
    total = front_pad + L
    n_chunks = -(-total // CHUNK)
    end_pad = n_chunks * CHUNK - total

    def blocks(t):
        t = jnp.pad(t.astype(jnp.float32), ((0, 0), (front_pad, end_pad), (0, 0), (0, 0)))
        t = t.reshape(B, n_chunks, CHUNK, t.shape[2], t.shape[3])
        return jnp.moveaxis(t, 1, 0)

    o, S = _gla_scan(blocks(q), blocks(k), blocks(v), blocks(log_a), S0.astype(jnp.float32))
    o = jnp.moveaxis(o, 0, 1).reshape(B, n_chunks * CHUNK, GLA_HEADS, GLA_DV_HEAD)
    return o[:, front_pad:front_pad + L], S


def _pool_mix(p, buf, pos0):
    B, L, W = p.shape
    z = jnp.concatenate([buf, p], axis=1)
    cs = jnp.concatenate([jnp.zeros((B, 1, W), jnp.float32), jnp.cumsum(z, axis=1)], axis=1)
    pos = pos0 + jnp.arange(L)
    outs = []
    for gi, w in enumerate(POOL_WINDOWS):
        lo, hi = gi * POOL_GROUP, (gi + 1) * POOL_GROUP
        s = cs[:, POOL_BUF + 1:POOL_BUF + 1 + L, lo:hi] - cs[:, POOL_BUF + 1 - w:POOL_BUF + 1 - w + L, lo:hi]
        cnt = jnp.minimum(w, pos + 1).astype(jnp.float32)[None, :, None]
        outs.append(s / cnt - p[..., lo:hi])
    mixed = jnp.stack(outs, axis=2)
    return mixed, z[:, -POOL_BUF:]


def _mixer(xn, S0, pool_buf, pool_pos0, front_pad, w_in, w_alpha2, b_alpha, gla_norm_g, w_pool, pool_scale, w_out):
    B, L, _ = xn.shape
    proj = xn @ w_in
    cuts = [int(c) for c in np.cumsum(IN_SPLITS)[:-1]]
    q, k, v, r, a_lr, p, g_a, g_b = jnp.split(proj, cuts, axis=-1)
    q = q.reshape(B, L, GLA_HEADS, GLA_DK_HEAD) * (GLA_DK_HEAD ** -0.5)
    k = k.reshape(B, L, GLA_HEADS, GLA_DK_HEAD)
    v = v.reshape(B, L, GLA_HEADS, GLA_DV_HEAD)
    log_a = jax.nn.log_sigmoid((a_lr @ w_alpha2 + b_alpha).astype(jnp.float32)) / GATE_TAU
    log_a = log_a.reshape(B, L, GLA_HEADS, GLA_DK_HEAD)
    o, S = _gla(q, k, v, log_a, S0, front_pad)
    o = o * lax.rsqrt(jnp.mean(o * o, axis=-1, keepdims=True) + EPS)
    o = o.reshape(B, L, GLA_DV) * gla_norm_g.astype(jnp.float32)
    y_a = jax.nn.silu(r.astype(jnp.float32)) * o
    mixed, new_buf = _pool_mix(p.astype(jnp.float32), pool_buf.astype(jnp.float32), pool_pos0)
    y_b = jnp.einsum('blgc,gcd->blgd', mixed, w_pool.astype(jnp.float32)).reshape(B, L, D_MODEL)
    y_b = y_b * pool_scale.astype(jnp.float32)
    merged = jax.nn.sigmoid(g_a.astype(jnp.float32)) * y_a + jax.nn.sigmoid(g_b.astype(jnp.float32)) * y_b
    out = (merged @ w_out.astype(jnp.float32)).astype(xn.dtype)
    return out, S, new_buf


def _layer(x, S0, pool_buf, pool_pos0, front_pad, n_drop, norm1_g, w_in, w_alpha2, b_alpha, gla_norm_g,
           w_pool, pool_scale, w_out, norm2_g, w_ffn_gate, w_ffn_up, w_ffn_down, norm_f_g):
    mix, S, buf = _mixer(_rmsnorm(x, norm1_g), S0, pool_buf, pool_pos0, front_pad,
                         w_in, w_alpha2, b_alpha, gla_norm_g, w_pool, pool_scale, w_out)
    h = (x + mix)[:, n_drop:]
    hn = _rmsnorm(h, norm2_g)
    h = h + (jax.nn.silu(hn @ w_ffn_gate) * (hn @ w_ffn_up)) @ w_ffn_down
    return _rmsnorm(h, norm_f_g), S, buf


def setup_inputs(seed: int = 0) -> dict:
    key = jax.random.key(seed)
    ks = jax.random.split(key, 18)

    def n(k, shape, scale):
        return jax.random.normal(k, shape, jnp.float32) * scale

    return {
        'x_prompt': n(ks[0], (BATCH, SEQ, D_MODEL), 1.0),
        'x_sample': n(ks[1], (DEC_BATCH, DEC_SEQ, D_MODEL), 1.0),
        'state_gla': n(ks[2], (DEC_BATCH, GLA_HEADS, GLA_DK_HEAD, GLA_DV_HEAD), 1.0),
        'state_pool': n(ks[3], (DEC_BATCH, POOL_BUF, POOL_WIDTH), 1.0),
        'meta_tokens': n(ks[4], (N_META, D_MODEL), 1.0),
        'norm1_g': 1.0 + n(ks[5], (D_MODEL,), 0.02),
        'w_in': n(ks[6], (D_MODEL, D_IN), D_MODEL ** -0.5),
        'w_alpha2': n(ks[7], (GATE_RANK, GLA_DK), GATE_RANK ** -0.5),
        'b_alpha': n(ks[8], (GLA_DK,), 0.1),
        'gla_norm_g': 1.0 + n(ks[9], (GLA_DV,), 0.02),
        'w_pool': n(ks[10], (POOL_GROUPS, POOL_GROUP, POOL_OUT_GROUP), POOL_GROUP ** -0.5),
        'pool_scale': 1.0 + n(ks[11], (D_MODEL,), 0.1),
        'w_out': n(ks[12], (D_MODEL, D_MODEL), D_MODEL ** -0.5),
        'norm2_g': 1.0 + n(ks[13], (D_MODEL,), 0.02),
        'w_ffn_gate': n(ks[14], (D_MODEL, D_FF), D_MODEL ** -0.5),
        'w_ffn_up': n(ks[15], (D_MODEL, D_FF), D_MODEL ** -0.5),
        'w_ffn_down': n(ks[16], (D_FF, D_MODEL), D_FF ** -0.5),
        'norm_f_g': 1.0 + n(ks[17], (D_MODEL,), 0.02),
    }


def reference(x_prompt, x_sample, state_gla, state_pool, meta_tokens, norm1_g, w_in, w_alpha2, b_alpha,
              gla_norm_g, w_pool, pool_scale, w_out, norm2_g, w_ffn_gate, w_ffn_up, w_ffn_down, norm_f_g):
    B = x_prompt.shape[0]
    meta = jnp.broadcast_to(meta_tokens[None].astype(x_prompt.dtype), (B, N_META, D_MODEL))
    xp = jnp.concatenate([meta, x_prompt], axis=1)
    S0 = jnp.zeros((B, GLA_HEADS, GLA_DK_HEAD, GLA_DV_HEAD), jnp.float32)
    buf0 = jnp.zeros((B, POOL_BUF, POOL_WIDTH), jnp.float32)
    y_prompt, S_p, buf_p = _layer(xp, S0, buf0, 0, (-N_META) % CHUNK, N_META, norm1_g, w_in, w_alpha2, b_alpha,
                                  gla_norm_g, w_pool, pool_scale, w_out, norm2_g, w_ffn_gate, w_ffn_up,
                                  w_ffn_down, norm_f_g)
    y_sample, S_s, buf_s = _layer(x_sample, state_gla, state_pool, PAST_LEN, 0, 0, norm1_g, w_in, w_alpha2, b_alpha,
                                  gla_norm_g, w_pool, pool_scale, w_out, norm2_g, w_ffn_gate, w_ffn_up,
                                  w_ffn_down, norm_f_g)
    return (y_prompt, y_sample,
            S_p.astype(state_gla.dtype), buf_p.astype(state_pool.dtype),
            S_s.astype(state_gla.dtype), buf_s.astype(state_pool.dtype))
```

```cpp
#include <hip/hip_runtime.h>
#include <cstdio>
#include <cstdint>
namespace pg8 {
#define PG8_LAS __attribute__((address_space(3)))
typedef unsigned short bf16_t;
typedef short bf16x8 __attribute__((ext_vector_type(8)));
typedef float f32x4 __attribute__((ext_vector_type(4)));
typedef unsigned u32x4 __attribute__((ext_vector_type(4)));
constexpr int BM = 256, BK = 64, HALF = 128, HTB = HALF * BK * 2  , STAGE_BYTES = 8 * HTB, NXCD = 8, WGM = 8;

__host__ __device__ __forceinline__ int lds_byte(int r, int c) { const int st = (r >> 4) * 2 + (c >> 5), rr = r & 15, cc = c & 31, ob = rr * 64 + cc * 2; return st * 1024 + (ob ^ (((ob >> 9) & 1) << 5)); }
__host__ __device__ __forceinline__ void stage_rc(int b, int& R, int& C) { const int st = b / 1024, sb = b % 1024, swz = sb ^ (((sb >> 9) & 1) << 5); R = (st >> 1) * 16 + swz / 64; C = (st & 1) * 32 + (swz % 64) / 2; }
__host__ __device__ __forceinline__ int perm32(int rho) { const int n = rho >> 4, i = rho & 15; return 8 * (i >> 2) + 4 * n + (i & 3); }

struct Unit { int pm, pn; };
struct Gemm { const bf16_t* A; const bf16_t* Bt; int M, N, K; };

struct StaticOrder {
    int nM, nN, nwg, G, c;
    __host__ __device__ void init(int M, int N, int G_, int c_) { nM = M / BM; nN = N / BM; nwg = nM * nN; G = G_; c = c_; }
    __host__ __device__ bool next(int i, Unit& u) const {
        const long L = (long)i * G + c; if (L >= nwg) return false;
        int wgid = (int)L; { const int q = nwg / NXCD, r = nwg % NXCD, xcd = wgid % NXCD, off = wgid / NXCD; wgid = (xcd < r ? xcd * (q + 1) : r * (q + 1) + (xcd - r) * q) + off; }
        const int nig = WGM * nN, gid = wgid / nig, fm = gid * WGM, gsz = (nM - fm) < WGM ? (nM - fm) : WGM;
        u.pm = fm + ((wgid % nig) % gsz); u.pn = (wgid % nig) / gsz; return true;
    }
    __device__ __forceinline__ void a_ready(const Unit&) const {}
    __device__ __forceinline__ void done(const Unit&) const {}
};

__device__ __forceinline__ unsigned cvt_pk_bf16(float lo, float hi) { unsigned r; asm volatile("v_cvt_pk_bf16_f32 %0, %1, %2" : "=v"(r) : "v"(lo), "v"(hi)); return r; }
typedef float f32x2 __attribute__((ext_vector_type(2)));
typedef unsigned u32x2 __attribute__((ext_vector_type(2)));
constexpr float RMS_EPS = 1e-6f;
__device__ __forceinline__ float fast_exp(float x) { return __builtin_amdgcn_exp2f(x * 1.44269504089f); }
__device__ __forceinline__ float fast_sigmoid(float x) { return __builtin_amdgcn_rcpf(1.0f + fast_exp(-x)); }
__device__ __forceinline__ float dot4(const f32x4 a) { return (a[0] * a[0] + a[1] * a[1]) + (a[2] * a[2] + a[3] * a[3]); }
__device__ __forceinline__ u32x4 pack8(const f32x4 v0, const f32x4 v1) { u32x4 w; w.x = cvt_pk_bf16(v0[0], v0[1]); w.y = cvt_pk_bf16(v0[2], v0[3]); w.z = cvt_pk_bf16(v1[0], v1[1]); w.w = cvt_pk_bf16(v1[2], v1[3]); return w; }

struct EpiProj {
    static constexpr bool PERM = true, AFTER_DRAIN = false;
    bf16_t* O; int ldc; bf16_t* ALR; int alr_tile;
    __device__ __forceinline__ void operator()(const f32x4 (&acc)[2][2][4][2], const Unit& u, int wr, int wc, int fr, int fq) const {
        const int row0 = u.pm * BM + wr * 64 + fr;
        if (u.pn == alr_tile) {
            if (wc == 0 && fq < 2) {
#pragma unroll
                for (int ai = 0; ai < 2; ++ai)
#pragma unroll
                    for (int m = 0; m < 4; ++m) *(u32x4*)(ALR + (size_t)(row0 + ai * HALF + m * 16) * 16 + 8 * fq) = pack8(acc[ai][0][m][0], acc[ai][0][m][1]);
            }
            return;
        }
        const int col0 = u.pn * BM + wc * 32 + 8 * fq;
#pragma unroll
        for (int ai = 0; ai < 2; ++ai)
#pragma unroll
            for (int m = 0; m < 4; ++m) { bf16_t* rowp = O + (size_t)(row0 + ai * HALF + m * 16) * ldc + col0;
#pragma unroll
                for (int bj = 0; bj < 2; ++bj) *(u32x4*)(rowp + bj * HALF) = pack8(acc[ai][bj][m][0], acc[ai][bj][m][1]); }
    }
};
struct EpiOut {
    static constexpr bool PERM = true, AFTER_DRAIN = false;
    const float* xp; const float* xs; int n_prompt_rows; float* out; bf16_t* HB; float* SS;
    __device__ __forceinline__ void operator()(const f32x4 (&acc)[2][2][4][2], const Unit& u, int wr, int wc, int fr, int fq) const {
        const int row0 = u.pm * BM + wr * 64 + fr, col0 = u.pn * BM + wc * 32 + 8 * fq;
        const bool prm = (u.pm * BM) < n_prompt_rows;
#pragma unroll
        for (int ai = 0; ai < 2; ++ai)
#pragma unroll
            for (int m = 0; m < 4; ++m) { const int row = row0 + ai * HALF + m * 16;
                const float* xr = prm ? xp + (size_t)row * 1024 : xs + (size_t)(row - n_prompt_rows) * 1024;
                float ss = 0.f;
#pragma unroll
                for (int bj = 0; bj < 2; ++bj) { const int c = col0 + bj * HALF;
                    const f32x4 h0 = *(const f32x4*)(xr + c) + acc[ai][bj][m][0], h1 = *(const f32x4*)(xr + c + 4) + acc[ai][bj][m][1];
                    float* op = out + (size_t)row * 1024 + c; *(f32x4*)op = h0; *(f32x4*)(op + 4) = h1;
                    *(u32x4*)(HB + (size_t)row * 1024 + c) = pack8(h0, h1);
                    ss += dot4(h0) + dot4(h1); }
                ss += __shfl_xor(ss, 16); ss += __shfl_xor(ss, 32);
                if (fq == 0) SS[(size_t)row * 16 + u.pn * 4 + wc] = ss; }
    }
};
struct EpiGU {
    static constexpr bool PERM = true, AFTER_DRAIN = false;
    const float* SS; bf16_t* ACT; int ldact;
    __device__ __forceinline__ void operator()(const f32x4 (&acc)[2][2][4][2], const Unit& u, int wr, int wc, int fr, int fq) const {
        const int row0 = u.pm * BM + wr * 64 + fr, col0 = u.pn * HALF + wc * 32 + 8 * fq;
#pragma unroll
        for (int ai = 0; ai < 2; ++ai)
#pragma unroll
            for (int m = 0; m < 4; ++m) { const int row = row0 + ai * HALF + m * 16;
                const f32x4* sp = (const f32x4*)(SS + (size_t)row * 16);
                const f32x4 s4 = (sp[0] + sp[1]) + (sp[2] + sp[3]);
                const float rstd = __builtin_amdgcn_rsqf(((s4[0] + s4[1]) + (s4[2] + s4[3])) * (1.0f / 1024.0f) + RMS_EPS);
                f32x4 a[2];
#pragma unroll
                for (int n = 0; n < 2; ++n)
#pragma unroll
                    for (int j = 0; j < 4; ++j) { const float g = acc[ai][0][m][n][j] * rstd, up = acc[ai][1][m][n][j] * rstd; a[n][j] = g * up * fast_sigmoid(g); }
                *(u32x4*)(ACT + (size_t)row * ldact + col0) = pack8(a[0], a[1]); }
    }
};
struct EpiDown {
    static constexpr bool PERM = true, AFTER_DRAIN = false;
    float* out; float* SS;
    __device__ __forceinline__ void operator()(const f32x4 (&acc)[2][2][4][2], const Unit& u, int wr, int wc, int fr, int fq) const {
        const int row0 = u.pm * BM + wr * 64 + fr, col0 = u.pn * BM + wc * 32 + 8 * fq;
#pragma unroll
        for (int ai = 0; ai < 2; ++ai)
#pragma unroll
            for (int m = 0; m < 4; ++m) { const int row = row0 + ai * HALF + m * 16;
                float ss = 0.f;
#pragma unroll
                for (int bj = 0; bj < 2; ++bj) { float* op = out + (size_t)row * 1024 + col0 + bj * HALF;
                    const f32x4 h0 = *(const f32x4*)op + acc[ai][bj][m][0], h1 = *(const f32x4*)(op + 4) + acc[ai][bj][m][1];
                    *(f32x4*)op = h0; *(f32x4*)(op + 4) = h1;
                    ss += dot4(h0) + dot4(h1); }
                ss += __shfl_xor(ss, 16); ss += __shfl_xor(ss, 32);
                if (fq == 0) SS[(size_t)row * 16 + u.pn * 4 + wc] = ss; }
    }
};
template <class Epi, class Sched, bool ALIGN_EPI = false, bool SP2 = false>
__device__ __forceinline__ void gemm_phase(PG8_LAS unsigned char* lds, const Gemm g, const Sched& S, const Epi& E) {
    const int tid = threadIdx.x, wid = __builtin_amdgcn_readfirstlane(tid >> 6), lane = tid & 63, wr = wid >> 2, wc = wid & 3, fr = lane & 15, fq = lane >> 4;
    const int K = g.K, nt = K / BK;
    unsigned voffA[2], voffB[2];
#pragma unroll
    for (int i = 0; i < 2; ++i) { int R, C; stage_rc(tid * 16 + i * 8192, R, C); const int Rb = Epi::PERM ? ((R & ~31) + perm32(R & 31)) : R;
        voffA[i] = (unsigned)(R * K + C) * 2u; voffB[i] = (unsigned)(Rb * K + C) * 2u; }
    const size_t kstep = (size_t)(BK * 2);
    const size_t hstep = (size_t)HALF * K * 2;
    const size_t tstep = 2 * hstep;
    const unsigned ldsw = (unsigned)wid * 1024u;
    const int aoff = lds_byte(wr * 64 + fr, fq * 8), boff = lds_byte(wc * 32 + fr, fq * 8);
#define PG8_SA(b, h) (((b) * 2 + (h)) * HTB)
#define PG8_SB(b, h) ((4 + (b) * 2 + (h)) * HTB)
#define PG8_STAGE(bufoff, gbase, voff) do { _Pragma("unroll") for (int _i = 0; _i < 2; ++_i) \
        __builtin_amdgcn_global_load_lds((const unsigned*)((const char*)(gbase) + (voff)[_i]), (PG8_LAS unsigned*)(lds + (bufoff) + ldsw + _i * 8192), 16, 0, 0); } while (0)
#define PG8_LDA(dst, b, h) do { _Pragma("unroll") for (int m = 0; m < 4; ++m) _Pragma("unroll") for (int k = 0; k < 2; ++k) dst[m][k] = *(const PG8_LAS bf16x8*)(lds + PG8_SA(b, h) + aoff + m * 2048 + k * 1024); } while (0)
#define PG8_LDB(dst, b, h) do { _Pragma("unroll") for (int n = 0; n < 2; ++n) _Pragma("unroll") for (int k = 0; k < 2; ++k) dst[n][k] = *(const PG8_LAS bf16x8*)(lds + PG8_SB(b, h) + boff + n * 2048 + k * 1024); } while (0)
#define PG8_MMA(ai, bj, At, Bt) do { __builtin_amdgcn_s_setprio(1); _Pragma("unroll") for (int m = 0; m < 4; ++m) _Pragma("unroll") for (int n = 0; n < 2; ++n) _Pragma("unroll") for (int k = 0; k < 2; ++k) \
        acc[ai][bj][m][n] = __builtin_amdgcn_mfma_f32_16x16x32_bf16(Bt[n][k], At[m][k], acc[ai][bj][m][n], 0, 0, 0); __builtin_amdgcn_s_setprio(0); } while (0)
#define PG8_WAIT_V(n) asm volatile("s_waitcnt vmcnt(" #n ")" ::: "memory")
#define PG8_WAIT_L(n) asm volatile("s_waitcnt lgkmcnt(" #n ")" ::: "memory")
#define PG8_BAR __builtin_amdgcn_s_barrier()
#define PG8_SCHED __builtin_amdgcn_sched_barrier(0)
    Unit cur, nxt; int ui = 0;
    if (!S.next(0, cur)) return;
    f32x4 acc[2][2][4][2];
#pragma unroll
    for (int a = 0; a < 2; ++a)
#pragma unroll
        for (int b = 0; b < 2; ++b)
#pragma unroll
            for (int m = 0; m < 4; ++m)
#pragma unroll
                for (int n = 0; n < 2; ++n) acc[a][b][m][n] = (f32x4){0.f, 0.f, 0.f, 0.f};
    bf16x8 At[4][2], B0[2][2], B1[2][2];
    const char* cA = (const char*)g.A + (size_t)cur.pm * tstep; const char* cB = (const char*)g.Bt + (size_t)cur.pn * tstep;
    S.a_ready(cur);
    if constexpr (SP2) {
        PG8_STAGE(PG8_SB(0, 0), cB, voffB); PG8_STAGE(PG8_SB(0, 1), cB + hstep, voffB); PG8_STAGE(PG8_SA(0, 0), cA, voffA); PG8_STAGE(PG8_SA(0, 1), cA + hstep, voffA);
        if (wr == 1) PG8_BAR;
        PG8_WAIT_V(2); PG8_BAR;
        PG8_STAGE(PG8_SB(1, 0), cB + kstep, voffB); PG8_STAGE(PG8_SA(1, 0), cA + kstep, voffA); PG8_STAGE(PG8_SB(1, 1), cB + hstep + kstep, voffB);
        PG8_WAIT_V(6); PG8_BAR;
    } else {
        PG8_STAGE(PG8_SB(0, 0), cB, voffB); PG8_STAGE(PG8_SA(0, 0), cA, voffA); PG8_STAGE(PG8_SB(0, 1), cB + hstep, voffB); PG8_STAGE(PG8_SA(0, 1), cA + hstep, voffA);
        if (wr == 1) PG8_BAR;
        PG8_WAIT_V(4); PG8_BAR;
        PG8_STAGE(PG8_SB(1, 0), cB + kstep, voffB); PG8_STAGE(PG8_SA(1, 0), cA + kstep, voffA); PG8_STAGE(PG8_SB(1, 1), cB + hstep + kstep, voffB);
        PG8_WAIT_V(6); PG8_BAR;
    }
    for (;;) {
        const bool has_next = S.next(ui + 1, nxt);
        const char* nA = has_next ? (const char*)g.A + (size_t)nxt.pm * tstep : cA; const char* nB = has_next ? (const char*)g.Bt + (size_t)nxt.pn * tstep : cB;
        for (int t = 0; t < nt; t += 2) {
            const bool last = (t == nt - 2);
            const char* a1 = cA + (size_t)(t + 1) * kstep;
            const char* a2 = last ? nA : cA + (size_t)(t + 2) * kstep; const char* b2 = last ? nB : cB + (size_t)(t + 2) * kstep;
            const char* a3 = a2 + kstep; const char* b3 = b2 + kstep;
            if (last && has_next) S.a_ready(nxt);
            if constexpr (SP2) {
            PG8_LDB(B0, 0, 0); PG8_LDB(B1, 0, 1); PG8_SCHED; PG8_LDA(At, 0, 0); PG8_STAGE(PG8_SA(1, 1), a1 + hstep, voffA);
            PG8_WAIT_V(8); PG8_WAIT_L(0); PG8_BAR; PG8_MMA(0, 0, At, B0); PG8_MMA(0, 1, At, B1); PG8_BAR; PG8_SCHED;
            PG8_LDA(At, 0, 1); PG8_STAGE(PG8_SB(0, 0), b2, voffB); PG8_STAGE(PG8_SB(0, 1), b2 + hstep, voffB); PG8_STAGE(PG8_SA(0, 0), a2, voffA);
            PG8_WAIT_V(8); PG8_WAIT_L(0); PG8_BAR; PG8_MMA(1, 0, At, B0); PG8_MMA(1, 1, At, B1); PG8_BAR; PG8_SCHED;
            PG8_LDB(B0, 1, 0); PG8_LDB(B1, 1, 1); PG8_SCHED; PG8_LDA(At, 1, 0); PG8_STAGE(PG8_SA(0, 1), a2 + hstep, voffA);
            PG8_WAIT_V(8); PG8_WAIT_L(0); PG8_BAR; PG8_MMA(0, 0, At, B0); PG8_MMA(0, 1, At, B1); PG8_BAR; PG8_SCHED;
            PG8_LDA(At, 1, 1); PG8_STAGE(PG8_SB(1, 0), b3, voffB); PG8_STAGE(PG8_SB(1, 1), b3 + hstep, voffB); PG8_STAGE(PG8_SA(1, 0), a3, voffA);
            PG8_WAIT_V(8); PG8_WAIT_L(0); PG8_BAR; PG8_MMA(1, 0, At, B0); PG8_MMA(1, 1, At, B1); PG8_BAR; PG8_SCHED;
            } else {
            PG8_LDB(B0, 0, 0); PG8_SCHED; PG8_LDA(At, 0, 0); PG8_STAGE(PG8_SA(1, 1), a1 + hstep, voffA);
            PG8_WAIT_L(8); PG8_BAR; PG8_WAIT_L(0); PG8_MMA(0, 0, At, B0); PG8_BAR; PG8_SCHED;
            PG8_LDB(B1, 0, 1); PG8_STAGE(PG8_SB(0, 0), b2, voffB);
            PG8_BAR; PG8_WAIT_L(0); PG8_MMA(0, 1, At, B1); PG8_BAR;
            PG8_LDA(At, 0, 1); PG8_STAGE(PG8_SA(0, 0), a2, voffA);
            PG8_BAR; PG8_WAIT_L(0); PG8_MMA(1, 0, At, B0); PG8_BAR; PG8_SCHED;
            PG8_STAGE(PG8_SB(0, 1), b2 + hstep, voffB);
            PG8_WAIT_V(6); PG8_BAR; PG8_MMA(1, 1, At, B1); PG8_BAR;
            PG8_LDB(B0, 1, 0); PG8_SCHED; PG8_LDA(At, 1, 0); PG8_STAGE(PG8_SA(0, 1), a2 + hstep, voffA);
            PG8_WAIT_L(8); PG8_BAR; PG8_WAIT_L(0); PG8_MMA(0, 0, At, B0); PG8_BAR; PG8_SCHED;
            PG8_LDB(B1, 1, 1); PG8_STAGE(PG8_SB(1, 0), b3, voffB);
            PG8_BAR; PG8_WAIT_L(0); PG8_MMA(0, 1, At, B1); PG8_BAR;
            PG8_LDA(At, 1, 1); PG8_STAGE(PG8_SA(1, 0), a3, voffA);
            PG8_BAR; PG8_WAIT_L(0); PG8_MMA(1, 0, At, B0); PG8_BAR; PG8_SCHED;
            PG8_STAGE(PG8_SB(1, 1), b3 + hstep, voffB);
            PG8_WAIT_V(6); PG8_BAR; PG8_MMA(1, 1, At, B1); PG8_BAR;
            }
        }
        if constexpr (ALIGN_EPI) { if (wr == 0) PG8_BAR; }
        if constexpr (!Epi::AFTER_DRAIN) { E(acc, cur, wr, wc, fr, fq); S.done(cur); }
        if (!has_next) break;
#pragma unroll
        for (int a = 0; a < 2; ++a)
#pragma unroll
            for (int b = 0; b < 2; ++b)
#pragma unroll
                for (int m = 0; m < 4; ++m)
#pragma unroll
                    for (int n = 0; n < 2; ++n) acc[a][b][m][n] = (f32x4){0.f, 0.f, 0.f, 0.f};
        cur = nxt; cA = nA; cB = nB; ++ui;
        if constexpr (ALIGN_EPI) { if (wr == 1) PG8_BAR; }
    }
    PG8_WAIT_V(0);
    if constexpr (!ALIGN_EPI) { if (wr == 0) PG8_BAR; }
    PG8_BAR;
    if constexpr (Epi::AFTER_DRAIN) { E.fused(acc, cur, wr, wc, fr, fq, lds, wid, lane); S.done(cur); }
#undef PG8_SA
#undef PG8_SB
#undef PG8_STAGE
#undef PG8_LDA
#undef PG8_LDB
#undef PG8_MMA
#undef PG8_WAIT_V
#undef PG8_WAIT_L
#undef PG8_BAR
#undef PG8_SCHED
}
}
#define GAS __attribute__((address_space(1)))
#define LAS __attribute__((address_space(3)))
typedef unsigned short bf16;
typedef unsigned v4u __attribute__((ext_vector_type(4)));
typedef float f32x4 __attribute__((ext_vector_type(4)));
typedef short bf16x8 __attribute__((ext_vector_type(8)));
typedef GAS unsigned gu32;
typedef GAS unsigned long long gu64;
#define RLX_AGENT __ATOMIC_RELAXED, __HIP_MEMORY_SCOPE_AGENT
#define LDS_WAIT() asm volatile("s_waitcnt lgkmcnt(0)" ::: "memory")
#define VM_WAIT() asm volatile("s_waitcnt vmcnt(0)" ::: "memory")
__device__ __forceinline__ unsigned long long rt() { return __builtin_amdgcn_s_memrealtime(); }
__device__ __forceinline__ unsigned f2bf(float f) { unsigned u = __builtin_bit_cast(unsigned, f); return (u + 0x7fffu + ((u >> 16) & 1u)) >> 16; }
__device__ __forceinline__ unsigned pk2(float lo, float hi) { return f2bf(lo) | (f2bf(hi) << 16); }

#define XB_TMO      128
#define XB_XCNT(j)  (256  + 64 * (j))
#define XB_XSUB(j)  (1280 + 64 * (j))
#define XB_XGEN(j)  (2304 + 64 * (j))
#define XB_TOP      3328
#define XB_TOPGEN   3392
#define XCD_BAR_WORDS 3456
#define XB_SPIN_CAP (1u << 18)

__device__ __forceinline__ unsigned xb_ld(unsigned* p)              { return __hip_atomic_load(p, __ATOMIC_RELAXED, __HIP_MEMORY_SCOPE_AGENT); }
__device__ __forceinline__ unsigned xb_add(unsigned* p, unsigned v) { return __hip_atomic_fetch_add(p, v, __ATOMIC_RELAXED, __HIP_MEMORY_SCOPE_AGENT); }
__device__ __forceinline__ unsigned xb_xcc_id() { return (unsigned)__builtin_amdgcn_s_getreg((3 << 11) | 20) & 0xFu; }
#define XB_SPIN(cond, bar) do { unsigned _sp = 0; while (cond) { __builtin_amdgcn_s_sleep(1); \
    if ((++_sp & 255u) == 0u) { if (xb_ld(&(bar)[XB_TMO])) break; if (_sp > XB_SPIN_CAP) { atomicAdd(&(bar)[XB_TMO], 1u); break; } } } } while (0)

struct XcdBarrier {
    unsigned* bar; unsigned x;
    volatile LAS unsigned* st;
};

__device__ __forceinline__ XcdBarrier xcd_barrier_post(unsigned* bar, volatile LAS unsigned* st) {
    XcdBarrier b; b.bar = bar; b.x = xb_xcc_id(); b.st = st;
    if (threadIdx.x == 0) (void)xb_add(&bar[XB_XCNT(b.x)], 1u);
    return b;
}
__device__ __forceinline__ void xcd_barrier_complete(unsigned* bar, unsigned x, unsigned& nloc, unsigned& nx) {
    const unsigned G = gridDim.x * gridDim.y * gridDim.z;
    unsigned sum, cnt, mine, sp = 0u;
    for (;;) {
        sum = 0u; cnt = 0u; mine = 0u;
#pragma unroll
        for (unsigned j = 0; j < 16; ++j) { const unsigned c = xb_ld(&bar[XB_XCNT(j)]); sum += c; cnt += (c > 0u) ? 1u : 0u; mine = (j == x) ? c : mine; }
        if (sum == G) break;
        __builtin_amdgcn_s_sleep(1);
        if ((++sp & 255u) == 0u) { if (xb_ld(&bar[XB_TMO])) break; if (sp > XB_SPIN_CAP) { atomicAdd(&bar[XB_TMO], 1u); break; } }
    }
    nloc = mine > 0u ? mine : 1u; nx = cnt > 0u ? cnt : 1u;
}

__device__ __forceinline__ void xcd_barrier(const XcdBarrier& b) {
    asm volatile("s_waitcnt vmcnt(0)" ::: "memory");
    __syncthreads();
    if (threadIdx.x == 0) {
        unsigned* bar = b.bar;
        __builtin_amdgcn_s_waitcnt(0);
        unsigned nloc = b.st[0], nx = b.st[1];
        if (nloc == 0u) { xcd_barrier_complete(bar, b.x, nloc, nx); b.st[0] = nloc; b.st[1] = nx; }
        const unsigned old = xb_add(&bar[XB_XSUB(b.x)], 1u);
        const unsigned gen = old / nloc;
        if (old + 1u == (gen + 1u) * nloc) {
            __builtin_amdgcn_fence(__ATOMIC_RELEASE, "agent");
            asm volatile("s_waitcnt vmcnt(0)" ::: "memory");
            const unsigned og = xb_add(&bar[XB_TOP], 1u);
            const unsigned tg = og / nx;
            if (og + 1u == (tg + 1u) * nx) xb_add(&bar[XB_TOPGEN], 1u);
            else XB_SPIN(xb_ld(&bar[XB_TOPGEN]) == tg, bar);
            __builtin_amdgcn_fence(__ATOMIC_ACQUIRE, "agent");
            xb_add(&bar[XB_XGEN(b.x)], 1u);
            asm volatile("s_waitcnt vmcnt(0)" ::: "memory");
        } else {
            XB_SPIN(xb_ld(&bar[XB_XGEN(b.x)]) == gen, bar);
            __builtin_amdgcn_fence(__ATOMIC_ACQUIRE, "agent");
            asm volatile("s_waitcnt vmcnt(0)" ::: "memory");
        }
    }
    __syncthreads();
}

constexpr int NWAVES = 8;
constexpr int D = 1024, NB = 32, SEQ = 2048, DB = 16, DSEQ = 64, NMETA = 16;
constexpr int HEADS = 4, DKH = 128, DVH = 256, RANK = 16, PW = 512, PG = 128, PBUF = 15, DFF = 2816;
constexpr int MP = NB * SEQ;
constexpr int MS = DB * DSEQ;
constexpr int MO = MP + MS;
constexpr int ROW_META = MO;
constexpr int MIN_ROWS = MO + 256;
constexpr int NPROJ = 5632;
constexpr int C_Q = 0, C_K = 512, C_V = 1024, C_R = 2048, C_P = 3072, C_GA = 3584, C_GB = 4608;
constexpr int NIN = NPROJ + 256;
constexpr int NGU = 2 * DFF;
constexpr int D_IN = 5648;
constexpr size_t OFF_YP = 0, OFF_YS = (size_t)MP * D, OFF_SGP = OFF_YS + (size_t)MS * D, OFF_SPP = OFF_SGP + (size_t)NB * HEADS * DKH * DVH,
                 OFF_SGS = OFF_SPP + (size_t)NB * PBUF * PW, OFF_SPS = OFF_SGS + (size_t)DB * HEADS * DKH * DVH;
constexpr size_t MiB = 1u << 20;
constexpr size_t WS_CTL = 0, CTL_ZERO_BYTES = 1 * MiB;
constexpr size_t WS_WIN = 1 * MiB;
constexpr size_t WS_WOUT = 13 * MiB;
constexpr size_t WS_WGU = 15 * MiB;
constexpr size_t WS_WDN = 26 * MiB;
constexpr size_t WS_ALR = 32 * MiB;
constexpr size_t WS_SS2 = 35 * MiB;
constexpr size_t WS_SS3 = 40 * MiB;
constexpr size_t WS_XN = 48 * MiB;
constexpr size_t WS_MERGED = WS_XN;
constexpr size_t WS_PROJ = 180 * MiB;
constexpr size_t WS_ACT = WS_PROJ;
constexpr size_t WS_HB = WS_PROJ + 360 * MiB;
constexpr size_t WS_END = WS_PROJ + (size_t)MIN_ROWS * NPROJ * 2;
static_assert(WS_WIN + (size_t)NIN * D * 2 <= WS_WOUT && WS_WGU + (size_t)NGU * D * 2 <= WS_WDN && WS_WDN + (size_t)D * DFF * 2 <= WS_ALR, "ws map (weights)");
static_assert(WS_ALR + (size_t)MIN_ROWS * 32 <= WS_SS2 && WS_SS2 + (size_t)MO * 64 <= WS_SS3 && WS_SS3 + (size_t)MO * 64 <= WS_XN, "ws map (small)");
static_assert(WS_XN + (size_t)MIN_ROWS * D * 2 <= WS_PROJ && WS_ACT + (size_t)MO * DFF * 2 <= WS_HB && WS_HB + (size_t)MO * D * 2 <= WS_END, "ws map (big)");
constexpr int CW_TMO = 0, CW_CODE = 1, CW_BAR = 4096;
constexpr int RING_OFF = 0, RING_BYTES = 131072;
constexpr int LDSCTL_OFF = RING_BYTES, MISC_OFF = LDSCTL_OFF + 320;
constexpr int LDS_BYTES = 147456;

struct Frame {
    LAS unsigned char* lds;
    volatile LAS unsigned* MISC;
    gu32* ctl;
    int tid, lane, wave, vcu, G;
};
__device__ __forceinline__ float wave_sum(float v) {
#pragma unroll
    for (int o = 1; o < 64; o <<= 1) v += __shfl_xor(v, o);
    return v;
}
__device__ __forceinline__ float bf2f(unsigned short u) { return __builtin_bit_cast(float, (unsigned)u << 16); }
__device__ __forceinline__ float bflo(unsigned u) { return __builtin_bit_cast(float, u << 16); }
__device__ __forceinline__ float bfhi(unsigned u) { return __builtin_bit_cast(float, u & 0xffff0000u); }

__device__ __forceinline__ void p0_transpose_item(const float* W, int ldw, int k0, int n0, int ncols, bf16* WT, int ldt, int dst_row0, const float* ksc, float sc, LAS float* scr, int lane) {
#pragma unroll 8
    for (int i = 0; i < 32; ++i) { const int kk = 2 * i + (lane >> 5), n = lane & 31;
        float v = (n < ncols) ? W[(size_t)(k0 + kk) * ldw + n0 + n] : 0.f;
        v *= (ksc ? ksc[k0 + kk] : 1.0f) * sc;
        scr[kk * 33 + n] = v; }
    LDS_WAIT(); asm volatile("" ::: "memory");
    const int c = lane & 7;
#pragma unroll
    for (int j = 0; j < 4; ++j) { const int n = (lane >> 3) + 8 * j; const LAS float* s = scr + (8 * c) * 33 + n;
        v4u o; o.x = pk2(s[0 * 33], s[1 * 33]); o.y = pk2(s[2 * 33], s[3 * 33]); o.z = pk2(s[4 * 33], s[5 * 33]); o.w = pk2(s[6 * 33], s[7 * 33]);
        if (n < ncols) *(GAS v4u*)(WT + (size_t)(dst_row0 + n) * ldt + k0 + 8 * c) = o; }
    LDS_WAIT(); asm volatile("" ::: "memory");
}
__device__ __forceinline__ void rms_row_to_bf16(const float* xrow, const float* gain, bf16* orow, int lane) {
    const GAS f32x4* xr = (const GAS f32x4*)xrow + lane; const GAS f32x4* gr = (const GAS f32x4*)gain + lane;
    f32x4 v[4]; float s = 0.f;
#pragma unroll
    for (int j = 0; j < 4; ++j) { v[j] = xr[64 * j]; s += (v[j].x * v[j].x + v[j].y * v[j].y) + (v[j].z * v[j].z + v[j].w * v[j].w); }
    const float rstd = 1.0f / sqrtf(wave_sum(s) * (1.f / D) + 1e-6f);
    GAS unsigned long long* o8 = (GAS unsigned long long*)orow + lane;
#pragma unroll
    for (int j = 0; j < 4; ++j) { const f32x4 g = gr[64 * j];
        o8[64 * j] = (unsigned long long)pk2(v[j].x * rstd * g.x, v[j].y * rstd * g.y) | ((unsigned long long)pk2(v[j].z * rstd * g.z, v[j].w * rstd * g.w) << 32); }
}

struct Args { const float* in[18]; float* out; unsigned char* ws; };

__device__ __forceinline__ void p0_prologue(Frame& F, const Args& A) {
    unsigned char* ws = A.ws;
    LAS float* scr = (LAS float*)(F.lds + RING_OFF + F.wave * 16384);
    const int gw = F.vcu * NWAVES + F.wave, NGW = F.G * NWAVES;
    const float* w_in = A.in[6]; const float* w_out = A.in[12]; const float* g2 = A.in[13];
    const float* w_gate = A.in[14]; const float* w_up = A.in[15]; const float* w_dn = A.in[16];
    bf16* WIN = (bf16*)(ws + WS_WIN); bf16* WOUT = (bf16*)(ws + WS_WOUT); bf16* WGU = (bf16*)(ws + WS_WGU); bf16* WDN = (bf16*)(ws + WS_WDN);
    constexpr int KB = D / 64;
    constexpr int I_IN_A = KB * (3072 / 32);
    constexpr int I_IN_L = KB * 1;
    constexpr int I_IN_C = KB * (2560 / 32);
    constexpr int I_OUT = KB * (D / 32);
    constexpr int I_G = KB * (DFF / 32), I_U = I_G;
    constexpr int I_DN = (DFF / 64) * (D / 32);
    constexpr int NITEMS = I_IN_A + I_IN_L + I_IN_C + I_OUT + I_G + I_U + I_DN;
    const float qsc = 0.08838834764831845f;
    for (int it = gw; it < NITEMS; it += NGW) {
        int r = it;
        if (r < I_IN_A) { const int kb = r / 96, nb = r % 96; p0_transpose_item(w_in, D_IN, 64 * kb, 32 * nb, 32, WIN, D, 32 * nb, nullptr, (nb < 16) ? qsc : 1.0f, scr, F.lane); continue; } r -= I_IN_A;
        if (r < I_IN_L) { p0_transpose_item(w_in, D_IN, 64 * r, 3072, 16, WIN, D, NPROJ, nullptr, 1.0f, scr, F.lane); continue; } r -= I_IN_L;
        if (r < I_IN_C) { const int kb = r / 80, nb = r % 80; p0_transpose_item(w_in, D_IN, 64 * kb, 3088 + 32 * nb, 32, WIN, D, 3072 + 32 * nb, nullptr, 1.0f, scr, F.lane); continue; } r -= I_IN_C;
        if (r < I_OUT) { const int kb = r / 32, nb = r % 32; p0_transpose_item(w_out, D, 64 * kb, 32 * nb, 32, WOUT, D, 32 * nb, nullptr, 1.0f, scr, F.lane); continue; } r -= I_OUT;
        if (r < I_G) { const int kb = r / 88, nb = r % 88; p0_transpose_item(w_gate, DFF, 64 * kb, 32 * nb, 32, WGU, D, (nb >> 2) * 256 + (nb & 3) * 32, g2, 1.0f, scr, F.lane); continue; } r -= I_G;
        if (r < I_U) { const int kb = r / 88, nb = r % 88; p0_transpose_item(w_up, DFF, 64 * kb, 32 * nb, 32, WGU, D, (nb >> 2) * 256 + 128 + (nb & 3) * 32, g2, 1.0f, scr, F.lane); continue; } r -= I_U;
        { const int kb = r / 32, nb = r % 32; p0_transpose_item(w_dn, D, 64 * kb, 32 * nb, 32, WDN, DFF, 32 * nb, nullptr, 1.0f, scr, F.lane); }
    }
    { GAS v4u* z = (GAS v4u*)(WIN + (size_t)(NPROJ + 16) * D); const int n16 = 240 * 2048 / 16; const v4u zero = {0u, 0u, 0u, 0u};
      for (int i = gw * 64 + F.lane; i < n16; i += NGW * 64) z[i] = zero; }
    bf16* XN = (bf16*)(ws + WS_XN); const float* g1 = A.in[5];
    for (int m = gw; m < MIN_ROWS; m += NGW) {
        bf16* orow = XN + (size_t)m * D;
        if (m < MP) rms_row_to_bf16(A.in[0] + (size_t)m * D, g1, orow, F.lane);
        else if (m < MO) rms_row_to_bf16(A.in[1] + (size_t)(m - MP) * D, g1, orow, F.lane);
        else if (m < MO + NMETA) rms_row_to_bf16(A.in[4] + (size_t)(m - MO) * D, g1, orow, F.lane);
        else { GAS unsigned long long* o8 = (GAS unsigned long long*)orow + F.lane;
#pragma unroll
            for (int j = 0; j < 4; ++j) o8[64 * j] = 0ull; }
    }
}

constexpr int G0_TB = 16;
constexpr int G0_QF = 0, G0_KF = 8192, G0_AF = 16384, G0_VF = 24576, G0_PH = 40960, G0_MIX = 56832, G0_OP = 65024, G0_RS = 97792;
__device__ __forceinline__ void gla_phase_v0(Frame& F, const Args& A) {
    unsigned char* ws = A.ws;
    const bf16* PROJ = (const bf16*)(ws + WS_PROJ); const bf16* ALR = (const bf16*)(ws + WS_ALR); bf16* MERGED = (bf16*)(ws + WS_MERGED);
    const float* w2 = A.in[7]; const float* b_alpha = A.in[8]; const float* gng = A.in[9]; const float* w_pool = A.in[10]; const float* pscale = A.in[11];
    LAS float* QF = (LAS float*)(F.lds + G0_QF); LAS float* KF = (LAS float*)(F.lds + G0_KF); LAS float* AF = (LAS float*)(F.lds + G0_AF);
    LAS float* VF = (LAS float*)(F.lds + G0_VF); LAS float* PH = (LAS float*)(F.lds + G0_PH); LAS float* MIX = (LAS float*)(F.lds + G0_MIX);
    LAS float* OP = (LAS float*)(F.lds + G0_OP); LAS float* RS = (LAS float*)(F.lds + G0_RS);
    const int tid = F.tid, dv = tid & 255, kh = tid >> 8;
    for (int u = F.vcu; u < 192; u += F.G) {
        const bool prm = u < 128; const int b = prm ? (u >> 2) : ((u - 128) >> 2), h = u & 3;
        const int win = 2 << h; const float rwin = 1.0f / (float)win;
        float S[64];
        if (prm) {
#pragma unroll
            for (int i = 0; i < 64; ++i) S[i] = 0.f;
        } else {
            const float* s0 = A.in[2] + ((size_t)(b * HEADS + h) * DKH + 64 * kh) * DVH + dv;
#pragma unroll
            for (int i = 0; i < 64; ++i) S[i] = s0[(size_t)i * DVH];
        }
        __syncthreads();
        for (int i = tid; i < PBUF * PG; i += 512) { const int j = i >> 7, c = i & 127; PH[i] = prm ? 0.f : A.in[3][(size_t)(b * PBUF + j) * PW + h * PG + c]; }
        const int nblk = prm ? (1 + SEQ / G0_TB) : (DSEQ / G0_TB);
        for (int blk = 0; blk < nblk; ++blk) {
            const int row0 = prm ? (blk == 0 ? ROW_META : b * SEQ + (blk - 1) * G0_TB) : (MP + b * DSEQ + blk * G0_TB);
            const bool emit = !(prm && blk == 0);
            __syncthreads();
            for (int i = tid; i < G0_TB * 128; i += 512) { const int t = i >> 7, k = i & 127; const bf16* pr = PROJ + (size_t)(row0 + t) * NPROJ;
                QF[i] = bf2f(pr[C_Q + h * DKH + k]); KF[i] = bf2f(pr[C_K + h * DKH + k]);
                float x = b_alpha[h * DKH + k]; const bf16* ar = ALR + (size_t)(row0 + t) * 16;
#pragma unroll
                for (int j = 0; j < 16; ++j) x += bf2f(ar[j]) * w2[j * 512 + h * DKH + k];
                const float ls = fminf(x, 0.f) - __logf(1.0f + __expf(-fabsf(x)));
                AF[i] = __expf(ls * (1.0f / 16.0f));
                PH[(PBUF + t) * 128 + k] = bf2f(pr[C_P + h * PG + k]); }
            for (int i = tid; i < G0_TB * 256; i += 512) { const int t = i >> 8, d = i & 255; VF[i] = bf2f(PROJ[(size_t)(row0 + t) * NPROJ + C_V + h * DVH + d]); }
            __syncthreads();
            for (int i = tid; i < G0_TB * 128; i += 512) { const int t = i >> 7, c = i & 127; float s = 0.f;
                for (int j = 0; j < win; ++j) s += PH[(PBUF + t - j) * 128 + c];
                MIX[i] = s * rwin - PH[(PBUF + t) * 128 + c]; }
            for (int t = 0; t < G0_TB; ++t) {
                const float vv = VF[t * 256 + dv]; float o = 0.f;
                const LAS f32x4* a4 = (const LAS f32x4*)(AF + t * 128 + 64 * kh); const LAS f32x4* k4 = (const LAS f32x4*)(KF + t * 128 + 64 * kh); const LAS f32x4* q4 = (const LAS f32x4*)(QF + t * 128 + 64 * kh);
#pragma unroll
                for (int kk = 0; kk < 16; ++kk) { const f32x4 a = a4[kk], kv = k4[kk], qv = q4[kk];
#pragma unroll
                    for (int j = 0; j < 4; ++j) { S[4 * kk + j] = S[4 * kk + j] * a[j] + kv[j] * vv; o += qv[j] * S[4 * kk + j]; } }
                OP[(kh * G0_TB + t) * 256 + dv] = o;
            }
            __syncthreads();
            if (emit) {
                float o8[8];
#pragma unroll
                for (int t8 = 0; t8 < 8; ++t8) { const int t = kh * 8 + t8; o8[t8] = OP[t * 256 + dv] + OP[(G0_TB + t) * 256 + dv];
                    const float ss = wave_sum(o8[t8] * o8[t8]); if (F.lane == 0) RS[t * 4 + (F.wave & 3)] = ss; }
                __syncthreads();
                float yb[8];
#pragma unroll
                for (int t8 = 0; t8 < 8; ++t8) yb[t8] = 0.f;
                const float* wp = w_pool + (size_t)h * PG * DVH + dv;
                for (int c = 0; c < PG; ++c) { const float w = wp[(size_t)c * DVH];
#pragma unroll
                    for (int t8 = 0; t8 < 8; ++t8) yb[t8] += MIX[(kh * 8 + t8) * 128 + c] * w; }
                const float gg = gng[h * DVH + dv], ps = pscale[h * DVH + dv];
#pragma unroll
                for (int t8 = 0; t8 < 8; ++t8) { const int t = kh * 8 + t8; const size_t row = (size_t)(row0 + t);
                    const float rstd = 1.0f / sqrtf(((RS[t * 4] + RS[t * 4 + 1]) + (RS[t * 4 + 2] + RS[t * 4 + 3])) * (1.0f / 256.0f) + 1e-6f);
                    const bf16* pr = PROJ + row * NPROJ + h * DVH + dv;
                    const float r = bf2f(pr[C_R]), ga = bf2f(pr[C_GA]), gb = bf2f(pr[C_GB]);
                    const float ya = r / (1.0f + __expf(-r)) * (o8[t8] * rstd * gg);
                    const float y_b = yb[t8] * ps;
                    const float mval = ya / (1.0f + __expf(-ga)) + y_b / (1.0f + __expf(-gb));
                    MERGED[row * D + h * DVH + dv] = (bf16)f2bf(mval); }
            }
            __syncthreads();
            float tmp[4];
#pragma unroll
            for (int q = 0; q < 4; ++q) { const int i = tid + 512 * q; tmp[q] = (i < PBUF * 128) ? PH[G0_TB * 128 + i] : 0.f; }
            __syncthreads();
#pragma unroll
            for (int q = 0; q < 4; ++q) { const int i = tid + 512 * q; if (i < PBUF * 128) PH[i] = tmp[q]; }
        }
        __syncthreads();
        { float* so = A.out + (prm ? OFF_SGP : OFF_SGS) + ((size_t)(b * HEADS + h) * DKH + 64 * kh) * DVH + dv;
#pragma unroll
          for (int i = 0; i < 64; ++i) so[(size_t)i * DVH] = S[i];
          float* po = A.out + (prm ? OFF_SPP : OFF_SPS);
          for (int i = tid; i < PBUF * PG; i += 512) { const int j = i >> 7, c = i & 127; po[(size_t)(b * PBUF + j) * PW + h * PG + c] = PH[i]; } }
    }
    __syncthreads();
}

__device__ __forceinline__ void final_norm_phase(Frame& F, const Args& A) {
    const int gw = F.vcu * NWAVES + F.wave, NGW = F.G * NWAVES;
    const float* SS = (const float*)(A.ws + WS_SS3); const GAS f32x4* gr = (const GAS f32x4*)A.in[17] + F.lane;
    f32x4 g[4];
#pragma unroll
    for (int j = 0; j < 4; ++j) g[j] = gr[64 * j];
    for (int m = gw; m < MO; m += NGW) {
        GAS f32x4* xr = (GAS f32x4*)(A.out + (size_t)m * D) + F.lane;
        const f32x4* sp = (const f32x4*)(SS + (size_t)m * 16);
        const f32x4 s4 = (sp[0] + sp[1]) + (sp[2] + sp[3]);
        const float rstd = 1.0f / sqrtf(((s4[0] + s4[1]) + (s4[2] + s4[3])) * (1.0f / 1024.0f) + 1e-6f);
#pragma unroll
        for (int j = 0; j < 4; ++j) { f32x4 v = xr[64 * j]; v = v * rstd * g[j]; xr[64 * j] = v; }
    }
}

__global__ void __launch_bounds__(NWAVES * 64, 2) fwd_mega(Args args) {
    extern __shared__ __attribute__((aligned(16))) unsigned char lds[];
    Frame F;
    F.lds = (LAS unsigned char*)lds;
    F.MISC = (volatile LAS unsigned*)(F.lds + MISC_OFF);
    F.tid = threadIdx.x; F.lane = F.tid & 63; F.wave = __builtin_amdgcn_readfirstlane(F.tid >> 6);
    F.G = gridDim.x; { const int bx = blockIdx.x; F.vcu = (F.G % 8 == 0) ? (bx % 8) * (F.G / 8) + bx / 8 : bx; }
    F.ctl = (gu32*)(args.ws + WS_CTL);
    for (int u = F.tid; u < (LDS_BYTES - LDSCTL_OFF) / 4; u += NWAVES * 64) ((LAS unsigned*)(F.lds + LDSCTL_OFF))[u] = 0u;
    __syncthreads();
    XcdBarrier bar = xcd_barrier_post((unsigned*)(F.ctl + CW_BAR), F.MISC + 8);
#define GRID_BAR() xcd_barrier(bar)
    unsigned char* ws = args.ws;
    p0_prologue(F, args);
    GRID_BAR();
    {   pg8::Gemm g{(const pg8::bf16_t*)(ws + WS_XN), (const pg8::bf16_t*)(ws + WS_WIN), MIN_ROWS, NIN, D};
        pg8::StaticOrder S; S.init(MIN_ROWS, NIN, F.G, (int)blockIdx.x);
        pg8::EpiProj E{(pg8::bf16_t*)(ws + WS_PROJ), NPROJ, (pg8::bf16_t*)(ws + WS_ALR), NPROJ / 256};
        pg8::gemm_phase<pg8::EpiProj, pg8::StaticOrder, true, true>(F.lds + RING_OFF, g, S, E);
    }
    GRID_BAR();
    gla_phase_v0(F, args);
    GRID_BAR();
    {   pg8::Gemm g{(const pg8::bf16_t*)(ws + WS_MERGED), (const pg8::bf16_t*)(ws + WS_WOUT), MO, D, D};
        pg8::StaticOrder S; S.init(MO, D, F.G, (int)blockIdx.x);
        pg8::EpiOut E{args.in[0], args.in[1], MP, args.out, (pg8::bf16_t*)(ws + WS_HB), (float*)(ws + WS_SS2)};
        pg8::gemm_phase<pg8::EpiOut, pg8::StaticOrder, true, true>(F.lds + RING_OFF, g, S, E);
    }
    GRID_BAR();
    {   pg8::Gemm g{(const pg8::bf16_t*)(ws + WS_HB), (const pg8::bf16_t*)(ws + WS_WGU), MO, NGU, D};
        pg8::StaticOrder S; S.init(MO, NGU, F.G, (int)blockIdx.x);
        pg8::EpiGU E{(const float*)(ws + WS_SS2), (pg8::bf16_t*)(ws + WS_ACT), DFF};
        pg8::gemm_phase<pg8::EpiGU, pg8::StaticOrder, true, true>(F.lds + RING_OFF, g, S, E);
    }
    GRID_BAR();
    {   pg8::Gemm g{(const pg8::bf16_t*)(ws + WS_ACT), (const pg8::bf16_t*)(ws + WS_WDN), MO, D, DFF};
        pg8::StaticOrder S; S.init(MO, D, F.G, (int)blockIdx.x);
        pg8::EpiDown E{args.out, (float*)(ws + WS_SS3)};
        pg8::gemm_phase<pg8::EpiDown, pg8::StaticOrder, true, true>(F.lds + RING_OFF, g, S, E);
    }
    GRID_BAR();
    final_norm_phase(F, args);
}

extern "C" void kernel_launch(void* const* d_in, const int* in_sizes, int n_in, void* d_out, int out_size, void* d_ws, size_t ws_size, hipStream_t stream) {
    static int grid = 0;
    if (grid == 0) {
        if (n_in != 18 || ws_size < WS_END) { fprintf(stderr, "kernel_launch: needs 18 inputs and >= %zu bytes of workspace; got n_in %d, ws %zu; nothing launched\n", (size_t)WS_END, n_in, ws_size); grid = -1; return; }
        int dev = 0, cus = 0, per_cu = 0;
        if (hipGetDevice(&dev) != hipSuccess || hipDeviceGetAttribute(&cus, hipDeviceAttributeMultiprocessorCount, dev) != hipSuccess) { grid = -1; return; }
        if (hipFuncSetAttribute((const void*)fwd_mega, hipFuncAttributeMaxDynamicSharedMemorySize, LDS_BYTES) != hipSuccess) { fprintf(stderr, "kernel_launch: hipFuncSetAttribute failed\n"); grid = -1; return; }
        if (hipOccupancyMaxActiveBlocksPerMultiprocessor(&per_cu, (const void*)fwd_mega, NWAVES * 64, LDS_BYTES) != hipSuccess || per_cu < 1) { fprintf(stderr, "kernel_launch: occupancy query reports %d\n", per_cu); }
        (void)hipGetLastError();
        grid = cus;
    }
    if (grid < 0) return;
    if (hipMemsetAsync((char*)d_ws + WS_CTL, 0, CTL_ZERO_BYTES, stream) != hipSuccess) { fprintf(stderr, "kernel_launch: memset failed\n"); return; }
    Args a{};
    for (int i = 0; i < 18; ++i) a.in[i] = (const float*)d_in[i];
    a.out = (float*)d_out; a.ws = (unsigned char*)d_ws;
    hipLaunchKernelGGL(fwd_mega, dim3(grid), dim3(NWAVES * 64), LDS_BYTES, stream, a);
}
```

```cpp
#include <hip/hip_runtime.h>
#include <cstdio>
#include <cstdint>
namespace pg8 {
#define PG8_LAS __attribute__((address_space(3)))
typedef unsigned short bf16_t;
typedef short bf16x8 __attribute__((ext_vector_type(8)));
typedef float f32x4 __attribute__((ext_vector_type(4)));
typedef unsigned u32x4 __attribute__((ext_vector_type(4)));
constexpr int BM = 256, BK = 64, HALF = 128, HTB = HALF * BK * 2  , STAGE_BYTES = 8 * HTB, NXCD = 8, WGM = 4;

__host__ __device__ __forceinline__ int lds_byte(int r, int c) { const int st = (r >> 4) * 2 + (c >> 5), rr = r & 15, cc = c & 31, ob = rr * 64 + cc * 2; return st * 1024 + (ob ^ (((ob >> 9) & 1) << 5)); }
__host__ __device__ __forceinline__ void stage_rc(int b, int& R, int& C) { const int st = b / 1024, sb = b % 1024, swz = sb ^ (((sb >> 9) & 1) << 5); R = (st >> 1) * 16 + swz / 64; C = (st & 1) * 32 + (swz % 64) / 2; }
__host__ __device__ __forceinline__ int perm32(int rho) { const int n = rho >> 4, i = rho & 15; return 8 * (i >> 2) + 4 * n + (i & 3); }

struct Unit { int pm, pn, k0, nkt, ks; };
struct Gemm { const bf16_t* A; const bf16_t* Bt; int M, N, K; };

struct StaticOrder {
    static constexpr bool SPLITK = false;
    int nM, nN, nwg, G, c;
    __host__ __device__ void init(int M, int N, int G_, int c_) { nM = M / BM; nN = N / BM; nwg = nM * nN; G = G_; c = c_; }
    __host__ __device__ bool next(int i, Unit& u) const {
        const long L = (long)i * G + c; if (L >= nwg) return false;
        int wgid = (int)L; { const int q = nwg / NXCD, r = nwg % NXCD, xcd = wgid % NXCD, off = wgid / NXCD; wgid = (xcd < r ? xcd * (q + 1) : r * (q + 1) + (xcd - r) * q) + off; }
        const int nig = WGM * nN, gid = wgid / nig, fm = gid * WGM, gsz = (nM - fm) < WGM ? (nM - fm) : WGM;
        u.pm = fm + ((wgid % nig) % gsz); u.pn = (wgid % nig) / gsz; return true;
    }
    __device__ __forceinline__ void a_ready(const Unit&) const {}
    __device__ __forceinline__ void done(const Unit&) const {}
};

struct SplitKOrder {
    static constexpr bool SPLITK = true;
    int nM, nN, total, G, c;
    __host__ __device__ void init(int M, int N, int G_, int c_) { nM = M / BM; nN = N / BM; total = nM * nN * 4; G = G_; c = c_; }
    __host__ __device__ bool next(int i, Unit& u) const {
        const long L = (long)i * G + c; if (L >= total) return false;
        const int tile = (int)L >> 2, ks = (int)L & 3;
        u.pm = tile % nM; u.pn = tile / nM; u.ks = ks; u.k0 = ks < 2 ? 12 * ks : 24 + 10 * (ks - 2); u.nkt = ks < 2 ? 12 : 10; return true;
    }
    __device__ __forceinline__ void a_ready(const Unit&) const {}
    __device__ __forceinline__ void done(const Unit&) const {}
};

__device__ __forceinline__ unsigned cvt_pk_bf16(float lo, float hi) { unsigned r; asm volatile("v_cvt_pk_bf16_f32 %0, %1, %2" : "=v"(r) : "v"(lo), "v"(hi)); return r; }
typedef float f32x2 __attribute__((ext_vector_type(2)));
typedef unsigned u32x2 __attribute__((ext_vector_type(2)));
constexpr float RMS_EPS = 1e-6f;
__device__ __forceinline__ float fast_exp(float x) { return __builtin_amdgcn_exp2f(x * 1.44269504089f); }
__device__ __forceinline__ float fast_sigmoid(float x) { return __builtin_amdgcn_rcpf(1.0f + fast_exp(-x)); }
__device__ __forceinline__ float dot4(const f32x4 a) { return (a[0] * a[0] + a[1] * a[1]) + (a[2] * a[2] + a[3] * a[3]); }
__device__ __forceinline__ u32x4 pack8(const f32x4 v0, const f32x4 v1) { u32x4 w; w.x = cvt_pk_bf16(v0[0], v0[1]); w.y = cvt_pk_bf16(v0[2], v0[3]); w.z = cvt_pk_bf16(v1[0], v1[1]); w.w = cvt_pk_bf16(v1[2], v1[3]); return w; }

struct EpiProj {
    static constexpr bool PERM = true, AFTER_DRAIN = false;
    bf16_t* O; int ldc; float* ALR;
    __device__ __forceinline__ void operator()(const f32x4 (&acc)[2][2][4][2], const Unit& u, int wr, int wc, int fr, int fq, const PG8_LAS unsigned char* side) const {
        bf16_t* tb = O + (size_t)(u.pm * BM) * ldc;
        unsigned off = (unsigned)(wr * 64 + fr) * (unsigned)ldc + (unsigned)(wc * 32 + 8 * fq);
        if (u.pn == 22) {
            if (wc == 0 && fq < 2) {
#pragma unroll
                for (int ai = 0; ai < 2; ++ai)
#pragma unroll
                    for (int m = 0; m < 4; ++m) { float* ap = ALR + (size_t)(u.pm * BM + wr * 64 + fr + ai * HALF + m * 16) * 16 + 8 * fq; *(f32x4*)ap = acc[ai][0][m][0]; *(f32x4*)(ap + 4) = acc[ai][0][m][1]; }
            }
        } else if (u.pn < 10) {
            off += (unsigned)(u.pn * BM);
#pragma unroll
            for (int ai = 0; ai < 2; ++ai)
#pragma unroll
                for (int m = 0; m < 4; ++m) { asm volatile("" : "+v"(off));
#pragma unroll
                    for (int bj = 0; bj < 2; ++bj) __builtin_nontemporal_store(pack8(acc[ai][bj][m][0], acc[ai][bj][m][1]), (u32x4*)(tb + (off + bj * HALF)));
                    off += (m == 3 ? 80u : 16u) * (unsigned)ldc; }
        } else if (u.pn < 18) {
            const int cl = (u.pn - 10) * HALF + wc * 32 + 8 * fq;
            const f32x4 g0 = *(const PG8_LAS f32x4*)(side + 4 * cl), g1 = *(const PG8_LAS f32x4*)(side + 4 * cl + 16);
            off += 2560u + (unsigned)((u.pn - 10) * HALF);
#pragma unroll
            for (int ai = 0; ai < 2; ++ai)
#pragma unroll
                for (int m = 0; m < 4; ++m) { f32x4 rr0 = acc[ai][0][m][0], rr1 = acc[ai][0][m][1], qq0 = acc[ai][1][m][0], qq1 = acc[ai][1][m][1];
                    asm volatile("" : "+v"(off), "+v"(rr0), "+v"(rr1), "+v"(qq0), "+v"(qq1));
                    f32x4 a[2];
#pragma unroll
                    for (int j = 0; j < 4; ++j) { const float r0 = rr0[j], r1 = rr1[j];
                        a[0][j] = r0 * g0[j] * __builtin_amdgcn_rcpf((1.0f + fast_exp(-r0)) * (1.0f + fast_exp(-qq0[j]))); a[1][j] = r1 * g1[j] * __builtin_amdgcn_rcpf((1.0f + fast_exp(-r1)) * (1.0f + fast_exp(-qq1[j]))); }
                    __builtin_nontemporal_store(pack8(a[0], a[1]), (u32x4*)(tb + off)); off += (m == 3 ? 80u : 16u) * (unsigned)ldc; __builtin_amdgcn_sched_barrier(0); }
        } else {
            const int cl = (u.pn - 18) * BM + wc * 32 + 8 * fq;
            off += 3584u + (unsigned)((u.pn - 18) * BM);
            const PG8_LAS unsigned char* ps = side + 4096 + 4 * cl;
            const f32x4 p00 = *(const PG8_LAS f32x4*)(ps), p01 = *(const PG8_LAS f32x4*)(ps + 16), p10 = *(const PG8_LAS f32x4*)(ps + 4 * HALF), p11 = *(const PG8_LAS f32x4*)(ps + 4 * HALF + 16);
#pragma unroll
            for (int ai = 0; ai < 2; ++ai)
#pragma unroll
                for (int m = 0; m < 4; ++m) { f32x4 x00 = acc[ai][0][m][0], x01 = acc[ai][0][m][1], x10 = acc[ai][1][m][0], x11 = acc[ai][1][m][1];
                    asm volatile("" : "+v"(off), "+v"(x00), "+v"(x01), "+v"(x10), "+v"(x11));
#pragma unroll
                    for (int bj = 0; bj < 2; ++bj) { f32x4 a[2];
#pragma unroll
                        for (int j = 0; j < 4; ++j) { a[0][j] = fast_sigmoid(bj ? x10[j] : x00[j]) * (bj ? p10[j] : p00[j]); a[1][j] = fast_sigmoid(bj ? x11[j] : x01[j]) * (bj ? p11[j] : p01[j]); }
                        __builtin_nontemporal_store(pack8(a[0], a[1]), (u32x4*)(tb + (off + bj * HALF))); }
                    off += (m == 3 ? 80u : 16u) * (unsigned)ldc; __builtin_amdgcn_sched_barrier(0); }
        }
    }
};
struct EpiOut {
    static constexpr bool PERM = true, AFTER_DRAIN = false;
    const float* xp; const float* xs; int n_prompt_rows; float* out; bf16_t* HB; float* SS;
    __device__ __forceinline__ void operator()(const f32x4 (&acc)[2][2][4][2], const Unit& u, int wr, int wc, int fr, int fq, const PG8_LAS unsigned char* side) const {
        const int row0 = u.pm * BM + wr * 64 + fr, col0 = u.pn * BM + wc * 32 + 8 * fq;
        const bool prm = (u.pm * BM) < n_prompt_rows;
#pragma unroll
        for (int ai = 0; ai < 2; ++ai)
#pragma unroll
            for (int m = 0; m < 4; ++m) { const int row = row0 + ai * HALF + m * 16;
                const float* xr = prm ? xp + (size_t)row * 1024 : xs + (size_t)(row - n_prompt_rows) * 1024;
                float ss = 0.f;
#pragma unroll
                for (int bj = 0; bj < 2; ++bj) { const int c = col0 + bj * HALF;
                    const f32x4 h0 = *(const f32x4*)(xr + c) + acc[ai][bj][m][0], h1 = *(const f32x4*)(xr + c + 4) + acc[ai][bj][m][1];
                    *(u32x4*)(HB + (size_t)row * 1024 + c) = pack8(h0, h1);
                    ss += dot4(h0) + dot4(h1); }
                ss += __shfl_xor(ss, 16); ss += __shfl_xor(ss, 32);
                if (fq == 0) SS[(size_t)row * 16 + u.pn * 4 + wc] = ss; }
    }
};
struct EpiGU {
    static constexpr bool PERM = true, AFTER_DRAIN = false;
    const float* SS; bf16_t* ACT; int ldact;
    int ntab;
    __device__ __forceinline__ void operator()(const f32x4 (&acc)[2][2][4][2], const Unit& u, int wr, int wc, int fr, int fq, const PG8_LAS unsigned char* side) const {
        const int row0 = u.pm * BM + wr * 64 + fr, col0 = u.pn * HALF + wc * 32 + 8 * fq;
        if (ntab > 0) {
            const PG8_LAS float* tab = (const PG8_LAS float*)side; const PG8_LAS int* tg = (const PG8_LAS int*)(tab + 8 * 256);
            int slot = 0;
#pragma unroll
            for (int q = 1; q < 8; ++q) if (tg[q] == u.pm) slot = q;
            const PG8_LAS float* tr = tab + slot * 256 + wr * 64 + fr;
#pragma unroll
            for (int ai = 0; ai < 2; ++ai)
#pragma unroll
                for (int m = 0; m < 4; ++m) { const int row = row0 + ai * HALF + m * 16;
                    const float rstd = tr[ai * HALF + m * 16];
                    const f32x2 nrl = {rstd * -1.44269504089f, rstd * -1.44269504089f}, r2 = {rstd * rstd, rstd * rstd}, one = {1.0f, 1.0f};
                    f32x4 a[2];
#pragma unroll
                    for (int n = 0; n < 2; ++n)
#pragma unroll
                        for (int j = 0; j < 4; j += 2) { const f32x2 ag = {acc[ai][0][m][n][j], acc[ai][0][m][n][j + 1]}, au = {acc[ai][1][m][n][j], acc[ai][1][m][n][j + 1]};
                            const f32x2 t = ag * nrl; const f32x2 d = (f32x2){__builtin_amdgcn_exp2f(t[0]), __builtin_amdgcn_exp2f(t[1])} + one;
                            const f32x2 q = {__builtin_amdgcn_rcpf(d[0]), __builtin_amdgcn_rcpf(d[1])}; const f32x2 r = ((ag * au) * r2) * q;
                            a[n][j] = r[0]; a[n][j + 1] = r[1]; }
                    __builtin_nontemporal_store(pack8(a[0], a[1]), (u32x4*)(ACT + (size_t)row * ldact + col0)); }
        } else {
#pragma unroll
            for (int ai = 0; ai < 2; ++ai)
#pragma unroll
                for (int m = 0; m < 4; ++m) { const int row = row0 + ai * HALF + m * 16;
                    const f32x4* sp = (const f32x4*)(SS + (size_t)row * 16);
                    const f32x4 s4 = (sp[0] + sp[1]) + (sp[2] + sp[3]);
                    const float rstd = __builtin_amdgcn_rsqf(((s4[0] + s4[1]) + (s4[2] + s4[3])) * (1.0f / 1024.0f) + RMS_EPS);
                    f32x4 a[2];
#pragma unroll
                    for (int n = 0; n < 2; ++n)
#pragma unroll
                        for (int j = 0; j < 4; ++j) { const float g = acc[ai][0][m][n][j] * rstd, up = acc[ai][1][m][n][j] * rstd; a[n][j] = g * up * fast_sigmoid(g); }
                    __builtin_nontemporal_store(pack8(a[0], a[1]), (u32x4*)(ACT + (size_t)row * ldact + col0)); }
        }
    }
};
struct EpiDown {
    static constexpr bool PERM = true, AFTER_DRAIN = false;
    float* SS; bf16_t* HB;
    __device__ __forceinline__ void operator()(const f32x4 (&acc)[2][2][4][2], const Unit& u, int wr, int wc, int fr, int fq, const PG8_LAS unsigned char* side) const {
        const int row0 = u.pm * BM + wr * 64 + fr, col0 = u.pn * BM + wc * 32 + 8 * fq;
#pragma unroll
        for (int ai = 0; ai < 2; ++ai)
#pragma unroll
            for (int m = 0; m < 4; ++m) { const int row = row0 + ai * HALF + m * 16;
                float ss = 0.f;
#pragma unroll
                for (int bj = 0; bj < 2; ++bj) { bf16_t* hp = HB + (size_t)row * 1024 + col0 + bj * HALF;
                    const u32x4 hw = *(const u32x4*)hp;
                    const f32x4 r0 = {__builtin_bit_cast(float, hw.x << 16), __builtin_bit_cast(float, hw.x & 0xffff0000u), __builtin_bit_cast(float, hw.y << 16), __builtin_bit_cast(float, hw.y & 0xffff0000u)};
                    const f32x4 r1 = {__builtin_bit_cast(float, hw.z << 16), __builtin_bit_cast(float, hw.z & 0xffff0000u), __builtin_bit_cast(float, hw.w << 16), __builtin_bit_cast(float, hw.w & 0xffff0000u)};
                    const f32x4 h0 = r0 + acc[ai][bj][m][0], h1 = r1 + acc[ai][bj][m][1];
                    *(u32x4*)hp = pack8(h0, h1);
                    ss += dot4(h0) + dot4(h1); }
                ss += __shfl_xor(ss, 16); ss += __shfl_xor(ss, 32);
                if (fq == 0) SS[(size_t)row * 16 + u.pn * 4 + wc] = ss; }
    }
};
struct EpiPart {
    static constexpr bool PERM = true, AFTER_DRAIN = false;
    float* P; int M;
    __device__ __forceinline__ void operator()(const f32x4 (&acc)[2][2][4][2], const Unit& u, int wr, int wc, int fr, int fq, const PG8_LAS unsigned char* side) const {
        float* pb = P + (size_t)u.ks * M * 1024;
        const int row0 = u.pm * BM + wr * 64 + fr, col0 = u.pn * BM + wc * 32 + 8 * fq;
#pragma unroll
        for (int ai = 0; ai < 2; ++ai)
#pragma unroll
            for (int m = 0; m < 4; ++m) { const int row = row0 + ai * HALF + m * 16;
#pragma unroll
                for (int bj = 0; bj < 2; ++bj) { float* p = pb + (size_t)row * 1024 + col0 + bj * HALF; *(f32x4*)p = acc[ai][bj][m][0]; *(f32x4*)(p + 4) = acc[ai][bj][m][1]; } }
    }
};
template <class Epi, class Sched, bool ALIGN_EPI = false, bool SP2 = false>
__device__ __forceinline__ void gemm_phase(PG8_LAS unsigned char* lds, const Gemm g, const Sched& S, const Epi& E) {
    int tid_ = threadIdx.x; asm volatile("" : "+v"(tid_));
    const int tid = tid_, wid = __builtin_amdgcn_readfirstlane(tid >> 6), lane = tid & 63, wr = wid >> 2, wc = wid & 3, fr = lane & 15, fq = lane >> 4;
    const int K = g.K, nt = K / BK;
    unsigned voffA[2], voffB[2];
#pragma unroll
    for (int i = 0; i < 2; ++i) { int R, C; stage_rc(tid * 16 + i * 8192, R, C); const int Rb = Epi::PERM ? ((R & ~31) + perm32(R & 31)) : R;
        voffA[i] = (unsigned)(R * K + C) * 2u; voffB[i] = (unsigned)(Rb * K + C) * 2u; }
    const size_t kstep = (size_t)(BK * 2);
    const size_t hstep = (size_t)HALF * K * 2;
    const size_t tstep = 2 * hstep;
    const unsigned ldsw = (unsigned)wid * 1024u;
    const int aoff = lds_byte(wr * 64 + fr, fq * 8), boff = lds_byte(wc * 32 + fr, fq * 8);
#define PG8_SA(b, h) (((b) * 2 + (h)) * HTB)
#define PG8_SB(b, h) ((4 + (b) * 2 + (h)) * HTB)
#define PG8_STAGE(bufoff, gbase, voff) do { _Pragma("unroll") for (int _i = 0; _i < 2; ++_i) \
        __builtin_amdgcn_global_load_lds((const unsigned*)((const char*)(gbase) + (voff)[_i]), (PG8_LAS unsigned*)(lds + (bufoff) + ldsw + _i * 8192), 16, 0, 0); } while (0)
#define PG8_LDA(dst, b, h) do { _Pragma("unroll") for (int m = 0; m < 4; ++m) _Pragma("unroll") for (int k = 0; k < 2; ++k) dst[m][k] = *(const PG8_LAS bf16x8*)(lds + PG8_SA(b, h) + aoff + m * 2048 + k * 1024); } while (0)
#define PG8_LDB(dst, b, h) do { _Pragma("unroll") for (int n = 0; n < 2; ++n) _Pragma("unroll") for (int k = 0; k < 2; ++k) dst[n][k] = *(const PG8_LAS bf16x8*)(lds + PG8_SB(b, h) + boff + n * 2048 + k * 1024); } while (0)
#define PG8_MMA(ai, bj, At, Bt) do { __builtin_amdgcn_s_setprio(1); _Pragma("unroll") for (int m = 0; m < 4; ++m) _Pragma("unroll") for (int n = 0; n < 2; ++n) _Pragma("unroll") for (int k = 0; k < 2; ++k) \
        acc[ai][bj][m][n] = __builtin_amdgcn_mfma_f32_16x16x32_bf16(Bt[n][k], At[m][k], acc[ai][bj][m][n], 0, 0, 0); __builtin_amdgcn_s_setprio(0); } while (0)
#define PG8_WAIT_V(n) asm volatile("s_waitcnt vmcnt(" #n ")" ::: "memory")
#define PG8_WAIT_L(n) asm volatile("s_waitcnt lgkmcnt(" #n ")" ::: "memory")
#define PG8_BAR __builtin_amdgcn_s_barrier()
#define PG8_SCHED __builtin_amdgcn_sched_barrier(0)
    Unit cur, nxt; int ui = 0;
    if (!S.next(0, cur)) return;
    f32x4 acc[2][2][4][2];
#pragma unroll
    for (int a = 0; a < 2; ++a)
#pragma unroll
        for (int b = 0; b < 2; ++b)
#pragma unroll
            for (int m = 0; m < 4; ++m)
#pragma unroll
                for (int n = 0; n < 2; ++n) acc[a][b][m][n] = (f32x4){0.f, 0.f, 0.f, 0.f};
    bf16x8 At[4][2], B0[2][2], B1[2][2];
    const char* cA = (const char*)g.A + (size_t)cur.pm * tstep; const char* cB = (const char*)g.Bt + (size_t)cur.pn * tstep;
    if constexpr (Sched::SPLITK) { cA += (size_t)cur.k0 * kstep; cB += (size_t)cur.k0 * kstep; }
    S.a_ready(cur);
    if constexpr (SP2) {
        PG8_STAGE(PG8_SB(0, 0), cB, voffB); PG8_STAGE(PG8_SB(0, 1), cB + hstep, voffB); PG8_STAGE(PG8_SA(0, 0), cA, voffA); PG8_STAGE(PG8_SA(0, 1), cA + hstep, voffA);
        if (wr == 1) PG8_BAR;
        PG8_WAIT_V(2); PG8_BAR;
        PG8_STAGE(PG8_SB(1, 0), cB + kstep, voffB); PG8_STAGE(PG8_SA(1, 0), cA + kstep, voffA); PG8_STAGE(PG8_SB(1, 1), cB + hstep + kstep, voffB);
        PG8_WAIT_V(6); PG8_BAR;
    } else {
        PG8_STAGE(PG8_SB(0, 0), cB, voffB); PG8_STAGE(PG8_SA(0, 0), cA, voffA); PG8_STAGE(PG8_SB(0, 1), cB + hstep, voffB); PG8_STAGE(PG8_SA(0, 1), cA + hstep, voffA);
        if (wr == 1) PG8_BAR;
        PG8_WAIT_V(4); PG8_BAR;
        PG8_STAGE(PG8_SB(1, 0), cB + kstep, voffB); PG8_STAGE(PG8_SA(1, 0), cA + kstep, voffA); PG8_STAGE(PG8_SB(1, 1), cB + hstep + kstep, voffB);
        PG8_WAIT_V(6); PG8_BAR;
    }
    for (;;) {
        const bool has_next = S.next(ui + 1, nxt);
        const char* nA = has_next ? (const char*)g.A + (size_t)nxt.pm * tstep : cA; const char* nB = has_next ? (const char*)g.Bt + (size_t)nxt.pn * tstep : cB;
        if constexpr (Sched::SPLITK) { if (has_next) { nA += (size_t)nxt.k0 * kstep; nB += (size_t)nxt.k0 * kstep; } }
        const int ntc = Sched::SPLITK ? cur.nkt : nt;
        for (int t = 0; t < ntc; t += 2) {
            const bool last = (t == ntc - 2);
            const char* a1 = cA + (size_t)(t + 1) * kstep;
            const char* a2 = last ? nA : cA + (size_t)(t + 2) * kstep; const char* b2 = last ? nB : cB + (size_t)(t + 2) * kstep;
            const char* a3 = a2 + kstep; const char* b3 = b2 + kstep;
            if (last && has_next) S.a_ready(nxt);
            if constexpr (SP2) {
            PG8_LDB(B0, 0, 0); PG8_LDB(B1, 0, 1); PG8_SCHED; PG8_LDA(At, 0, 0); PG8_STAGE(PG8_SA(1, 1), a1 + hstep, voffA);
            PG8_WAIT_V(8); PG8_WAIT_L(0); PG8_BAR; PG8_MMA(0, 0, At, B0); PG8_MMA(0, 1, At, B1); PG8_BAR; PG8_SCHED;
            PG8_LDA(At, 0, 1); PG8_STAGE(PG8_SB(0, 0), b2, voffB); PG8_STAGE(PG8_SB(0, 1), b2 + hstep, voffB); PG8_STAGE(PG8_SA(0, 0), a2, voffA);
            PG8_WAIT_V(8); PG8_WAIT_L(0); PG8_BAR; PG8_MMA(1, 0, At, B0); PG8_MMA(1, 1, At, B1); PG8_BAR; PG8_SCHED;
            PG8_LDB(B0, 1, 0); PG8_LDB(B1, 1, 1); PG8_SCHED; PG8_LDA(At, 1, 0); PG8_STAGE(PG8_SA(0, 1), a2 + hstep, voffA);
            PG8_WAIT_V(8); PG8_WAIT_L(0); PG8_BAR; PG8_MMA(0, 0, At, B0); PG8_MMA(0, 1, At, B1); PG8_BAR; PG8_SCHED;
            PG8_LDA(At, 1, 1); PG8_STAGE(PG8_SB(1, 0), b3, voffB); PG8_STAGE(PG8_SB(1, 1), b3 + hstep, voffB); PG8_STAGE(PG8_SA(1, 0), a3, voffA);
            PG8_WAIT_V(8); PG8_WAIT_L(0); PG8_BAR; PG8_MMA(1, 0, At, B0); PG8_MMA(1, 1, At, B1); PG8_BAR; PG8_SCHED;
            } else {
            PG8_LDB(B0, 0, 0); PG8_SCHED; PG8_LDA(At, 0, 0); PG8_STAGE(PG8_SA(1, 1), a1 + hstep, voffA);
            PG8_WAIT_L(8); PG8_BAR; PG8_WAIT_L(0); PG8_MMA(0, 0, At, B0); PG8_BAR; PG8_SCHED;
            PG8_LDB(B1, 0, 1); PG8_STAGE(PG8_SB(0, 0), b2, voffB);
            PG8_BAR; PG8_WAIT_L(0); PG8_MMA(0, 1, At, B1); PG8_BAR;
            PG8_LDA(At, 0, 1); PG8_STAGE(PG8_SA(0, 0), a2, voffA);
            PG8_BAR; PG8_WAIT_L(0); PG8_MMA(1, 0, At, B0); PG8_BAR; PG8_SCHED;
            PG8_STAGE(PG8_SB(0, 1), b2 + hstep, voffB);
            PG8_WAIT_V(6); PG8_BAR; PG8_MMA(1, 1, At, B1); PG8_BAR;
            PG8_LDB(B0, 1, 0); PG8_SCHED; PG8_LDA(At, 1, 0); PG8_STAGE(PG8_SA(0, 1), a2 + hstep, voffA);
            PG8_WAIT_L(8); PG8_BAR; PG8_WAIT_L(0); PG8_MMA(0, 0, At, B0); PG8_BAR; PG8_SCHED;
            PG8_LDB(B1, 1, 1); PG8_STAGE(PG8_SB(1, 0), b3, voffB);
            PG8_BAR; PG8_WAIT_L(0); PG8_MMA(0, 1, At, B1); PG8_BAR;
            PG8_LDA(At, 1, 1); PG8_STAGE(PG8_SA(1, 0), a3, voffA);
            PG8_BAR; PG8_WAIT_L(0); PG8_MMA(1, 0, At, B0); PG8_BAR; PG8_SCHED;
            PG8_STAGE(PG8_SB(1, 1), b3 + hstep, voffB);
            PG8_WAIT_V(6); PG8_BAR; PG8_MMA(1, 1, At, B1); PG8_BAR;
            }
        }
        if constexpr (ALIGN_EPI) { if (wr == 0) PG8_BAR; }
        if constexpr (!Epi::AFTER_DRAIN) { E(acc, cur, wr, wc, fr, fq, lds + STAGE_BYTES); S.done(cur); }
        if (!has_next) break;
#pragma unroll
        for (int a = 0; a < 2; ++a)
#pragma unroll
            for (int b = 0; b < 2; ++b)
#pragma unroll
                for (int m = 0; m < 4; ++m)
#pragma unroll
                    for (int n = 0; n < 2; ++n) acc[a][b][m][n] = (f32x4){0.f, 0.f, 0.f, 0.f};
        cur = nxt; cA = nA; cB = nB; ++ui;
        if constexpr (ALIGN_EPI) { if (wr == 1) PG8_BAR; }
    }
    PG8_WAIT_V(0);
    if constexpr (!ALIGN_EPI) { if (wr == 0) PG8_BAR; }
    PG8_BAR;
    if constexpr (Epi::AFTER_DRAIN) { E.fused(acc, cur, wr, wc, fr, fq, lds, wid, lane); S.done(cur); }
#undef PG8_SA
#undef PG8_SB
#undef PG8_STAGE
#undef PG8_LDA
#undef PG8_LDB
#undef PG8_MMA
#undef PG8_WAIT_V
#undef PG8_WAIT_L
#undef PG8_BAR
#undef PG8_SCHED
}
}
#define GAS __attribute__((address_space(1)))
#define LAS __attribute__((address_space(3)))
typedef unsigned short bf16;
typedef unsigned v4u __attribute__((ext_vector_type(4)));
typedef float f32x4 __attribute__((ext_vector_type(4)));
typedef short bf16x8 __attribute__((ext_vector_type(8)));
typedef GAS unsigned gu32;
typedef GAS unsigned long long gu64;
#define RLX_AGENT __ATOMIC_RELAXED, __HIP_MEMORY_SCOPE_AGENT
#define LDS_WAIT() asm volatile("s_waitcnt lgkmcnt(0)" ::: "memory")
#define VM_WAIT() asm volatile("s_waitcnt vmcnt(0)" ::: "memory")
__device__ __forceinline__ unsigned long long rt() { return __builtin_amdgcn_s_memrealtime(); }
__device__ __forceinline__ unsigned f2bf(float f) { unsigned u = __builtin_bit_cast(unsigned, f); return (u + 0x7fffu + ((u >> 16) & 1u)) >> 16; }
__device__ __forceinline__ unsigned pk2(float lo, float hi) { return f2bf(lo) | (f2bf(hi) << 16); }

#define XB_TMO      128
#define XB_XCNT(j)  (256  + 64 * (j))
#define XB_XSUB(j)  (1280 + 64 * (j))
#define XB_XGEN(j)  (2304 + 64 * (j))
#define XB_TOP      3328
#define XB_TOPGEN   3392
#define XCD_BAR_WORDS 3456
#define XB_SPIN_CAP (1u << 18)

__device__ __forceinline__ unsigned xb_ld(unsigned* p)              { return __hip_atomic_load(p, __ATOMIC_RELAXED, __HIP_MEMORY_SCOPE_AGENT); }
__device__ __forceinline__ unsigned xb_add(unsigned* p, unsigned v) { return __hip_atomic_fetch_add(p, v, __ATOMIC_RELAXED, __HIP_MEMORY_SCOPE_AGENT); }
__device__ __forceinline__ unsigned xb_xcc_id() { return (unsigned)__builtin_amdgcn_s_getreg((3 << 11) | 20) & 0xFu; }
#define XB_SPIN(cond, bar) do { unsigned _sp = 0; while (cond) { __builtin_amdgcn_s_sleep(1); \
    if ((++_sp & 255u) == 0u) { if (xb_ld(&(bar)[XB_TMO])) break; if (_sp > XB_SPIN_CAP) { atomicAdd(&(bar)[XB_TMO], 1u); break; } } } } while (0)

struct XcdBarrier {
    unsigned* bar; unsigned x;
    volatile LAS unsigned* st;
};

__device__ __forceinline__ XcdBarrier xcd_barrier_post(unsigned* bar, volatile LAS unsigned* st) {
    XcdBarrier b; b.bar = bar; b.x = xb_xcc_id(); b.st = st;
    if (threadIdx.x == 0) (void)xb_add(&bar[XB_XCNT(b.x)], 1u);
    return b;
}
__device__ __forceinline__ void xcd_barrier_complete(unsigned* bar, unsigned x, unsigned& nloc, unsigned& nx) {
    const unsigned G = gridDim.x * gridDim.y * gridDim.z;
    unsigned sum, cnt, mine, sp = 0u;
    for (;;) {
        sum = 0u; cnt = 0u; mine = 0u;
#pragma unroll
        for (unsigned j = 0; j < 16; ++j) { const unsigned c = xb_ld(&bar[XB_XCNT(j)]); sum += c; cnt += (c > 0u) ? 1u : 0u; mine = (j == x) ? c : mine; }
        if (sum == G) break;
        __builtin_amdgcn_s_sleep(1);
        if ((++sp & 255u) == 0u) { if (xb_ld(&bar[XB_TMO])) break; if (sp > XB_SPIN_CAP) { atomicAdd(&bar[XB_TMO], 1u); break; } }
    }
    nloc = mine > 0u ? mine : 1u; nx = cnt > 0u ? cnt : 1u;
}

__device__ __forceinline__ void xcd_barrier(const XcdBarrier& b) {
    asm volatile("s_waitcnt vmcnt(0)" ::: "memory");
    __syncthreads();
    if (threadIdx.x == 0) {
        unsigned* bar = b.bar;
        __builtin_amdgcn_s_waitcnt(0);
        unsigned nloc = b.st[0], nx = b.st[1];
        if (nloc == 0u) { xcd_barrier_complete(bar, b.x, nloc, nx); b.st[0] = nloc; b.st[1] = nx; }
        const unsigned old = xb_add(&bar[XB_XSUB(b.x)], 1u);
        const unsigned gen = old / nloc;
        if (old + 1u == (gen + 1u) * nloc) {
            __builtin_amdgcn_fence(__ATOMIC_RELEASE, "agent");
            asm volatile("s_waitcnt vmcnt(0)" ::: "memory");
            const unsigned og = xb_add(&bar[XB_TOP], 1u);
            const unsigned tg = og / nx;
            if (og + 1u == (tg + 1u) * nx) xb_add(&bar[XB_TOPGEN], 1u);
            else XB_SPIN(xb_ld(&bar[XB_TOPGEN]) == tg, bar);
            __builtin_amdgcn_fence(__ATOMIC_ACQUIRE, "agent");
            xb_add(&bar[XB_XGEN(b.x)], 1u);
            asm volatile("s_waitcnt vmcnt(0)" ::: "memory");
        } else {
            XB_SPIN(xb_ld(&bar[XB_XGEN(b.x)]) == gen, bar);
            __builtin_amdgcn_fence(__ATOMIC_ACQUIRE, "agent");
            asm volatile("s_waitcnt vmcnt(0)" ::: "memory");
        }
    }
    __syncthreads();
}

constexpr int NWAVES = 8;
constexpr int D = 1024, NB = 32, SEQ = 2048, DB = 16, DSEQ = 64, NMETA = 16;
constexpr int HEADS = 4, DKH = 128, DVH = 256, RANK = 16, PW = 512, PG = 128, PBUF = 15, DFF = 2816;
constexpr int MP = NB * SEQ;
constexpr int MS = DB * DSEQ;
constexpr int MO = MP + MS;
constexpr int ROW_META = MO;
constexpr int MIN_ROWS = MO + 256;
constexpr int NPROJ = 4608;
constexpr int C_Q = 0, C_K = 512, C_V = 1024, C_P = 2048, C_GA = 2560, C_GB = 3584;
constexpr int NIN = 5632;
constexpr int NIN_ALLOC = 5888;
constexpr int NGU = 2 * DFF;
constexpr int D_IN = 5648;
constexpr size_t OFF_YP = 0, OFF_YS = (size_t)MP * D, OFF_SGP = OFF_YS + (size_t)MS * D, OFF_SPP = OFF_SGP + (size_t)NB * HEADS * DKH * DVH,
                 OFF_SGS = OFF_SPP + (size_t)NB * PBUF * PW, OFF_SPS = OFF_SGS + (size_t)DB * HEADS * DKH * DVH;
constexpr size_t MiB = 1u << 20;
constexpr size_t WS_CTL = 0, CTL_ZERO_BYTES = 1 * MiB;
constexpr size_t WS_WIN = 1 * MiB;
constexpr size_t WS_WOUT = 13 * MiB;
constexpr size_t WS_WGU = 15 * MiB;
constexpr size_t WS_WDN = 26 * MiB;
constexpr size_t WS_ALR = 32 * MiB;
constexpr size_t WS_WPT = 36 * MiB + 512 * 1024;
constexpr size_t WS_EXPBL = 37 * MiB;
constexpr size_t WS_SS2 = 40 * MiB;
constexpr size_t WS_SS3 = 44 * MiB + 512 * 1024;
constexpr size_t WS_XN = 50 * MiB;
constexpr size_t WS_MERGED = WS_XN;
constexpr size_t WS_PROJ = 182 * MiB;
constexpr size_t WS_ACT = WS_PROJ;
constexpr size_t WS_HB = WS_PROJ + 360 * MiB;
constexpr size_t WS_PH = WS_PROJ + (size_t)MIN_ROWS * NPROJ * 2;
constexpr size_t WS_HBS = WS_PH + 256 * 1024;
constexpr size_t WS_ACTS = WS_HBS + 2 * MiB;
constexpr size_t WS_PART = WS_ACTS + 6 * MiB;
constexpr size_t WS_END = WS_PART + 16 * MiB;
static_assert(WS_WIN + (size_t)NIN_ALLOC * D * 2 <= WS_WOUT && WS_WGU + (size_t)NGU * D * 2 <= WS_WDN && WS_WDN + (size_t)D * DFF * 2 <= WS_ALR, "ws map (weights)");
static_assert(WS_ALR + (size_t)MIN_ROWS * 64 <= WS_WPT && WS_WPT + 4 * 256 * 128 * 2 <= WS_EXPBL && WS_EXPBL + (size_t)4288 * 512 <= WS_SS2 && WS_SS2 + (size_t)MO * 64 <= WS_SS3 && WS_SS3 + (size_t)MO * 64 <= WS_XN, "ws map (small)");
static_assert(WS_XN + (size_t)MIN_ROWS * D * 2 <= WS_PROJ && WS_ACT + (size_t)MO * DFF * 2 <= WS_HB && WS_HB + (size_t)MO * D * 2 <= WS_PH, "ws map (big)");
constexpr int N_HELP = 128;
constexpr int CW_TMO = 0, CW_CODE = 1, CW_BAR = 4096, CW_HBAR = 8192, CW_LATE = 8192 + 64 * 8, CW_WTICKET = CW_LATE + 64;
constexpr int RING_OFF = 0, RING_BYTES = 131072;
constexpr int LDS_BYTES = 155648;
constexpr int LDSCTL_OFF = LDS_BYTES - 512, MISC_OFF = LDSCTL_OFF + 320;
constexpr int TAB_OFF = RING_OFF + RING_BYTES;
static_assert(TAB_OFF + 8 * 1024 + 64 <= LDSCTL_OFF, "epilogue tables");

struct Frame {
    LAS unsigned char* lds;
    volatile LAS unsigned* MISC;
    gu32* ctl;
    int tid, lane, wave, vcu, G;
};
__device__ __forceinline__ float wave_sum(float v) {
#pragma unroll
    for (int o = 1; o < 64; o <<= 1) v += __shfl_xor(v, o);
    return v;
}
__device__ __forceinline__ float bf2f(unsigned short u) { return __builtin_bit_cast(float, (unsigned)u << 16); }
__device__ __forceinline__ float bflo(unsigned u) { return __builtin_bit_cast(float, u << 16); }
__device__ __forceinline__ float bfhi(unsigned u) { return __builtin_bit_cast(float, u & 0xffff0000u); }

__device__ __forceinline__ void p0_transpose_item(const float* W, int ldw, int k0, int n0, int ncols, bf16* WT, int ldt, int dst_row0, const float* ksc, float sc, LAS float* scr, int lane, const bool vperm = false) {
#pragma unroll 8
    for (int i = 0; i < 32; ++i) { const int kk = 2 * i + (lane >> 5), n = lane & 31;
        float v = (n < ncols) ? W[(size_t)(k0 + kk) * ldw + n0 + n] : 0.f;
        v *= (ksc ? ksc[k0 + kk] : 1.0f) * sc;
        scr[kk * 33 + n] = v; }
    LDS_WAIT(); asm volatile("" ::: "memory");
    const int c = lane & 7;
#pragma unroll
    for (int j = 0; j < 4; ++j) { const int n = (lane >> 3) + 8 * j; const LAS float* s = scr + (8 * c) * 33 + n;
        v4u o; o.x = pk2(s[0 * 33], s[1 * 33]); o.y = pk2(s[2 * 33], s[3 * 33]); o.z = pk2(s[4 * 33], s[5 * 33]); o.w = pk2(s[6 * 33], s[7 * 33]);
        const int nd = vperm ? (((n >> 2) & 1) * 16 + (n >> 3) * 4 + (n & 3)) : n;
        if (n < ncols) *(GAS v4u*)(WT + (size_t)(dst_row0 + nd) * ldt + k0 + 8 * c) = o; }
    LDS_WAIT(); asm volatile("" ::: "memory");
}
__device__ __forceinline__ void rms_row_to_bf16(const float* xrow, const float* gain, bf16* orow, int lane) {
    const GAS f32x4* xr = (const GAS f32x4*)xrow + lane; const GAS f32x4* gr = (const GAS f32x4*)gain + lane;
    f32x4 v[4]; float s = 0.f;
#pragma unroll
    for (int j = 0; j < 4; ++j) { v[j] = xr[64 * j]; s += (v[j].x * v[j].x + v[j].y * v[j].y) + (v[j].z * v[j].z + v[j].w * v[j].w); }
    const float rstd = 1.0f / sqrtf(wave_sum(s) * (1.f / D) + 1e-6f);
    GAS unsigned long long* o8 = (GAS unsigned long long*)orow + lane;
#pragma unroll
    for (int j = 0; j < 4; ++j) { const f32x4 g = gr[64 * j];
        o8[64 * j] = (unsigned long long)pk2(v[j].x * rstd * g.x, v[j].y * rstd * g.y) | ((unsigned long long)pk2(v[j].z * rstd * g.z, v[j].w * rstd * g.w) << 32); }
}

struct Args { const float* in[18]; float* out; unsigned char* ws; };
typedef const __attribute__((address_space(4))) char* kargp_t;
__device__ __forceinline__ const void* karg(unsigned idx) {
    unsigned off = idx * 8u; asm volatile("" : "+s"(off));
    kargp_t kp = (kargp_t)__builtin_amdgcn_kernarg_segment_ptr();
    return *(const void* const __attribute__((address_space(4)))*)(kp + off);
}
#define KIN(i) ((const float*)karg(i))
#define KOUT() ((float*)karg(18))
#define KWS() ((unsigned char*)karg(19))


namespace wi {
constexpr int KB = D / 64;
constexpr int I_IN = KB * 176;
constexpr int I_WP = 4 * 2 * 8;
constexpr int I_OUT = KB * (D / 32);
constexpr int I_G = KB * (DFF / 32), I_U = I_G;
constexpr int I_DN = (DFF / 64) * (D / 32);
constexpr int N_EARLY = I_IN + I_WP;
constexpr int N_LATE = I_OUT + I_G + I_U + I_DN;
}
__device__ __forceinline__ void p0_weight_item(Frame& F, int r, LAS float* scr) {
    using namespace wi;
    unsigned char* ws = KWS();
    const float qsc = 0.08838834764831845f;
    if (r < I_IN) { const float* w_in = KIN(6); bf16* WIN = (bf16*)(ws + WS_WIN);
        const int kb = r / 176, nbk = r % 176; int src, dst, nc = 32; float sc = 1.0f;
        if (nbk < 64) { src = 32 * nbk; dst = 32 * nbk; if (nbk < 16) sc = qsc; }
        else if (nbk < 80) { const int i = nbk - 64; src = 3088 + 32 * i; dst = 2048 + 32 * i; }
        else if (nbk < 144) { const int i = nbk - 80, j = i >> 3, hf = (i >> 2) & 1, sub = i & 3; src = (hf ? 3600 : 2048) + 128 * j + 32 * sub; dst = 2560 + 256 * j + 128 * hf + 32 * sub; }
        else { const int i = nbk - 144; src = 4624 + 32 * i; dst = 4608 + 32 * i; }
        p0_transpose_item(w_in, D_IN, 64 * kb, src, nc, WIN, D, dst, nullptr, sc, scr, F.lane, nbk >= 32 && nbk < 64); return; } r -= I_IN;
    if (r < I_WP) { const float* w_pool = KIN(10); const int gi = r >> 4, kb = (r >> 3) & 1, nb = r & 7;
        p0_transpose_item(w_pool + (size_t)gi * PG * DVH, DVH, 64 * kb, 32 * nb, 32, (bf16*)(ws + WS_WPT), PG, gi * DVH + 32 * nb, nullptr, 1.0f, scr, F.lane); return; } r -= I_WP;
    if (r < I_OUT) { const int kb = r / 32, nb = r % 32; p0_transpose_item(KIN(12), D, 64 * kb, 32 * nb, 32, (bf16*)(ws + WS_WOUT), D, 32 * nb, nullptr, 1.0f, scr, F.lane); return; } r -= I_OUT;
    if (r < I_G) { const int kb = r / 88, nb = r % 88; p0_transpose_item(KIN(14), DFF, 64 * kb, 32 * nb, 32, (bf16*)(ws + WS_WGU), D, (nb >> 2) * 256 + (nb & 3) * 32, KIN(13), 1.0f, scr, F.lane); return; } r -= I_G;
    if (r < I_U) { const int kb = r / 88, nb = r % 88; p0_transpose_item(KIN(15), DFF, 64 * kb, 32 * nb, 32, (bf16*)(ws + WS_WGU), D, (nb >> 2) * 256 + 128 + (nb & 3) * 32, KIN(13), 1.0f, scr, F.lane); return; } r -= I_U;
    { const int kb = r / 32, nb = r % 32; p0_transpose_item(KIN(16), D, 64 * kb, 32 * nb, 32, (bf16*)(ws + WS_WDN), DFF, 32 * nb, nullptr, 1.0f, scr, F.lane); }
}
__device__ __forceinline__ void late_weight_items(Frame& F, const int e, const int ne) {
    LAS float* scr = (LAS float*)(F.lds + RING_OFF + F.wave * 16384);
    for (int t = e * NWAVES + F.wave; t < wi::N_LATE; t += ne * NWAVES) p0_weight_item(F, wi::N_EARLY + t, scr);
}
__device__ __forceinline__ void p0_prologue(Frame& F) {
    unsigned char* ws = KWS();
    LAS float* scr = (LAS float*)(F.lds + RING_OFF + F.wave * 16384);
    const int gw = F.vcu * NWAVES + F.wave, NGW = F.G * NWAVES;
    bf16* WIN = (bf16*)(ws + WS_WIN);
    for (int it = gw; it < wi::N_EARLY; it += NGW) p0_weight_item(F, it, scr);
    { GAS v4u* z = (GAS v4u*)(WIN + (size_t)(5632 + 16) * D); const int n16 = 240 * 2048 / 16; const v4u zero = {0u, 0u, 0u, 0u};
      for (int i = gw * 64 + F.lane; i < n16; i += NGW * 64) z[i] = zero; }
    { const float* sp = KIN(3); bf16* PH = (bf16*)(ws + WS_PH); for (int i = gw * 64 + F.lane; i < DB * PBUF * PW; i += NGW * 64) PH[i] = (bf16)f2bf(sp[i]); }
    bf16* XN = (bf16*)(ws + WS_XN); const float* g1 = KIN(5); const float* xpr = KIN(0); const float* xsm = KIN(1); const float* xmt = KIN(4);
    float* ALRO = (float*)(ws + WS_ALR);
    constexpr int LP = 2064;
    LAS unsigned char* Wt = F.lds + RING_OFF;
    LAS unsigned char* At = F.lds + RING_OFF + 16 * LP + 256 + F.wave * (4 * LP + 192);
    __syncthreads();
    { const float* w_in = KIN(6); const int k0 = 2 * F.tid; const float* w0 = w_in + (size_t)k0 * D_IN + 3072;
#pragma unroll
      for (int q = 0; q < 4; ++q) { const f32x4 a = *(const f32x4*)(w0 + 4 * q), b = *(const f32x4*)(w0 + D_IN + 4 * q);
#pragma unroll
          for (int i = 0; i < 4; ++i) *(LAS unsigned*)(Wt + (4 * q + i) * LP + 2 * k0) = pk2(a[i], b[i]); } }
    __syncthreads();
    int lz = F.lane; asm volatile("" : "+v"(lz));
    const unsigned l15 = lz & 15, kq = lz >> 4;
    const LAS unsigned char* wrd = Wt + l15 * LP + 16 * kq;
    const LAS unsigned char* ard = At + (l15 & 3) * LP + 16 * kq;
    LAS unsigned char* awr = At + 8 * lz;
    const GAS f32x4* gr = (const GAS f32x4*)g1 + F.lane;
    f32x4 gv[4];
#pragma unroll
    for (int j = 0; j < 4; ++j) gv[j] = gr[64 * j];
#define P0_ROWPTR(m) (((m) < MP) ? xpr + (size_t)(m) * D : ((m) < MO) ? xsm + (size_t)((m) - MP) * D : xmt + (size_t)(((m) < MO + NMETA ? (m) : MO) - MO) * D)
    f32x4 vn[4][4];
    { const int m0 = 4 * gw;
      if (m0 < MIN_ROWS) {
#pragma unroll
        for (int r = 0; r < 4; ++r) { const GAS f32x4* xr = (const GAS f32x4*)P0_ROWPTR(m0 + r) + F.lane;
#pragma unroll
            for (int j = 0; j < 4; ++j) vn[r][j] = __builtin_nontemporal_load(&xr[64 * j]); } } }
    for (int m0 = 4 * gw; m0 < MIN_ROWS; m0 += 4 * NGW) {
        f32x4 v[4][4];
#pragma unroll
        for (int r = 0; r < 4; ++r)
#pragma unroll
            for (int j = 0; j < 4; ++j) v[r][j] = vn[r][j];
        { const int mn = (m0 + 4 * NGW < MIN_ROWS) ? m0 + 4 * NGW : m0;
#pragma unroll
          for (int r = 0; r < 4; ++r) { const GAS f32x4* xr = (const GAS f32x4*)P0_ROWPTR(mn + r) + F.lane;
#pragma unroll
              for (int j = 0; j < 4; ++j) vn[r][j] = __builtin_nontemporal_load(&xr[64 * j]); } }
#pragma unroll
        for (int r = 0; r < 4; ++r) { const int m = m0 + r; float s = 0.f;
#pragma unroll
            for (int j = 0; j < 4; ++j) s += (v[r][j].x * v[r][j].x + v[r][j].y * v[r][j].y) + (v[r][j].z * v[r][j].z + v[r][j].w * v[r][j].w);
            const float rstd = (m < MO + NMETA) ? 1.0f / sqrtf(wave_sum(s) * (1.f / D) + 1e-6f) : 0.f;
            GAS unsigned long long* o8 = (GAS unsigned long long*)(XN + (size_t)m * D) + F.lane;
#pragma unroll
            for (int j = 0; j < 4; ++j) { const f32x4 g = gv[j];
                const unsigned long long w_ = (unsigned long long)pk2(v[r][j].x * rstd * g.x, v[r][j].y * rstd * g.y) | ((unsigned long long)pk2(v[r][j].z * rstd * g.z, v[r][j].w * rstd * g.w) << 32);
                o8[64 * j] = w_; *(LAS unsigned long long*)(awr + r * LP + 512 * j) = w_; } }
        asm volatile("s_waitcnt lgkmcnt(0)" ::: "memory");
        f32x4 acc0 = {0.f, 0.f, 0.f, 0.f}, acc1 = acc0;
#pragma unroll
        for (int ks = 0; ks < 32; ks += 2) {
            acc0 = __builtin_amdgcn_mfma_f32_16x16x32_bf16(*(const LAS bf16x8*)(ard + 64 * ks), *(const LAS bf16x8*)(wrd + 64 * ks), acc0, 0, 0, 0);
            acc1 = __builtin_amdgcn_mfma_f32_16x16x32_bf16(*(const LAS bf16x8*)(ard + 64 * ks + 64), *(const LAS bf16x8*)(wrd + 64 * ks + 64), acc1, 0, 0, 0); }
        const f32x4 acc = acc0 + acc1;
        if (kq == 0) {
#pragma unroll
            for (int e = 0; e < 4; ++e) ALRO[(size_t)(m0 + e) * 16 + l15] = acc[e]; }
        asm volatile("s_waitcnt lgkmcnt(0)" ::: "memory");
    }
#undef P0_ROWPTR
    __syncthreads();
}


typedef short s16x4 __attribute__((ext_vector_type(4)));
typedef unsigned u32x2 __attribute__((ext_vector_type(2)));
typedef float f32x2g __attribute__((ext_vector_type(2)));
typedef __bf16 bf16x2n __attribute__((ext_vector_type(2)));
__device__ __forceinline__ unsigned pkbf(float a, float b) { f32x2g v = {a, b}; bf16x2n r = __builtin_convertvector(v, bf16x2n); return __builtin_bit_cast(unsigned, r); }
__device__ __forceinline__ unsigned off_b(unsigned row, unsigned ch) { return 256u * row + 16u * (ch ^ (((row & 3u) << 2) | ((row >> 2) & 3u))); }
#define MFMA16(a, b, c) __builtin_amdgcn_mfma_f32_16x16x32_bf16((a), (b), (c), 0, 0, 0)
__device__ __forceinline__ bf16x8 tr_frag(LAS unsigned char* img, unsigned lane, unsigned c, unsigned ks) {
    const unsigned g = lane >> 4, q = (lane & 15) >> 2, p = lane & 3;
    const unsigned a0 = off_b(32 * ks + 8 * g + q, 2 * c + (p >> 1)) + 8 * (p & 1), a1 = off_b(32 * ks + 8 * g + 4 + q, 2 * c + (p >> 1)) + 8 * (p & 1);
    const s16x4 lo = __builtin_amdgcn_ds_read_tr16_b64_v4i16((LAS s16x4*)(img + a0)), hi = __builtin_amdgcn_ds_read_tr16_b64_v4i16((LAS s16x4*)(img + a1));
    return __builtin_shufflevector(lo, hi, 0, 1, 2, 3, 4, 5, 6, 7);
}
__device__ __forceinline__ bf16x8 row_frag(LAS unsigned char* img, unsigned lane, unsigned rb, unsigned ks) { return *(const LAS bf16x8*)(img + off_b((lane & 15) + 16 * rb, 4 * ks + (lane >> 4))); }

constexpr int N_ITEMS_P = NB * HEADS * 33, N_ITEMS = N_ITEMS_P + DB * HEADS;
#define GLA_CBASE(prm, b, cc) ((prm) ? ((cc) == 0 ? ROW_META - 48 : (b) * SEQ + ((cc) - 1) * 64) : (MP + (b) * DSEQ))

constexpr int QK_STAGE = 32768;
constexpr int QK_ALR = 0;
typedef float f32x2q __attribute__((ext_vector_type(2)));
__device__ __forceinline__ f32x2q logsig16_pk(f32x2q x) {
    f32x2q r;
#pragma unroll
    for (int e = 0; e < 2; ++e) { const float xc = __builtin_amdgcn_fmed3f(x[e], -80.0f, 80.0f); r[e] = __builtin_amdgcn_logf(1.0f + __builtin_amdgcn_exp2f(xc * -1.44269504089f)) * (-0.69314718056f / 16.0f); }
    return r;
}
template <int TMIN>
__device__ __forceinline__ void gla_qk_item(bf16* PROJ, const float* ALRF, float* EXPBL, const float* w2, const float* b_alpha, LAS unsigned char* La, LAS unsigned char* Ls, const unsigned lane, const int item, const int cbase, const int h) {
    { const float* ap = ALRF + (size_t)cbase * 16;
#pragma unroll
      for (int q = 0; q < 4; ++q) { const unsigned i = lane + 64u * q; const f32x4 v = ((int)(i >> 2) >= TMIN) ? *(const f32x4*)(ap + 4u * i) : (f32x4){0.f, 0.f, 0.f, 0.f}; *(LAS f32x4*)(La + 16u * i) = v; } }
    f32x2q w2r[16];
#pragma unroll
    for (int j = 0; j < 16; ++j) w2r[j] = *(const f32x2q*)(w2 + j * 512 + h * DKH + 2 * lane);
    const f32x2q bias = *(const f32x2q*)(b_alpha + h * DKH + 2 * lane);
    asm volatile("s_waitcnt lgkmcnt(0)" ::: "memory");
    f32x2q bsum = {0.f, 0.f};
    LAS unsigned char* Lq = Ls, *Lk = Ls + 4096;
    const unsigned srow = lane >> 4, sch = lane & 15u;
    const bf16* qg = PROJ + (size_t)cbase * NPROJ + C_Q + h * DKH + 8u * sch; const bf16* kg = PROJ + (size_t)cbase * NPROJ + C_K + h * DKH + 8u * sch;
    v4u nq[4], nk[4];
#define QK_FETCH(qr) do { _Pragma("unroll") for (int i = 0; i < 4; ++i) { const unsigned t = 16u * (qr) + 4u * i + srow; nq[i] = *(const v4u*)(qg + t * NPROJ); nk[i] = *(const v4u*)(kg + t * NPROJ); } } while (0)
    constexpr int Q0 = TMIN / 16;
    QK_FETCH(Q0);
#pragma unroll 1
    for (int qr = Q0; qr < 4; ++qr) {
#pragma unroll
        for (int i = 0; i < 4; ++i) { *(LAS v4u*)(Lq + (4u * i + srow) * 256u + 16u * sch) = nq[i]; *(LAS v4u*)(Lk + (4u * i + srow) * 256u + 16u * sch) = nk[i]; }
        asm volatile("s_waitcnt lgkmcnt(0)" ::: "memory");
        { const int qn = (qr + 1 < 4) ? qr + 1 : qr; QK_FETCH(qn); }
#pragma unroll
        for (int r = 0; r < 16; ++r) { const int t = 16 * qr + r;
            const LAS f32x4* ar = (const LAS f32x4*)(La + t * 64); const f32x4 a0 = ar[0], a1 = ar[1], a2 = ar[2], a3 = ar[3];
            f32x2q x0 = bias, x1 = {0.f, 0.f};
#pragma unroll
            for (int j = 0; j < 4; ++j) { x0 += w2r[j] * a0[j]; x1 += w2r[4 + j] * a1[j]; x0 += w2r[8 + j] * a2[j]; x1 += w2r[12 + j] * a3[j]; }
            bsum += logsig16_pk(x0 + x1);
            const float e0 = pg8::fast_exp(bsum[0]), e1 = pg8::fast_exp(bsum[1]), n0 = pg8::fast_exp(-bsum[0]), n1 = pg8::fast_exp(-bsum[1]);
            LAS unsigned* qw = (LAS unsigned*)(Lq + r * 256 + 4u * lane); LAS unsigned* kw = (LAS unsigned*)(Lk + r * 256 + 4u * lane);
            const unsigned sq = *qw, sk = *kw;
            *qw = pkbf(bflo(sq) * e0, bfhi(sq) * e1); *kw = pkbf(bflo(sk) * n0, bfhi(sk) * n1); }
        asm volatile("s_waitcnt lgkmcnt(0)" ::: "memory");
#pragma unroll
        for (int i = 0; i < 4; ++i) { const unsigned t = 16u * qr + 4u * i + srow;
            *(v4u*)(const_cast<bf16*>(qg) + t * NPROJ) = *(const LAS v4u*)(Lq + (4u * i + srow) * 256u + 16u * sch); *(v4u*)(const_cast<bf16*>(kg) + t * NPROJ) = *(const LAS v4u*)(Lk + (4u * i + srow) * 256u + 16u * sch); }
        asm volatile("s_waitcnt lgkmcnt(0)" ::: "memory");
    }
#undef QK_FETCH
    *(f32x2q*)(EXPBL + (size_t)item * 128 + 2 * lane) = (f32x2q){pg8::fast_exp(bsum[0]), pg8::fast_exp(bsum[1])};
    asm volatile("s_waitcnt lgkmcnt(0)" ::: "memory");
}
__device__ __forceinline__ void gla_prep_qk(Frame& F, const int c_lo, const int c_hi, const bool with_sample, const int gw, const int NGW) {
    unsigned char* ws = KWS();
    bf16* PROJ = (bf16*)(ws + WS_PROJ); const float* ALRF = (const float*)(ws + WS_ALR); float* EXPBL = (float*)(ws + WS_EXPBL);
    const float* w2 = KIN(7); const float* b_alpha = KIN(8);
    int tid_ = F.tid; asm volatile("" : "+v"(tid_));
    const unsigned lane = (unsigned)tid_ & 63u;
    LAS unsigned char* La = F.lds + QK_ALR + F.wave * 4096;
    LAS unsigned char* Ls = F.lds + QK_STAGE + F.wave * 8192;
    const int nc = c_hi - c_lo, n_prompt = NB * HEADS * nc, total = n_prompt + (with_sample ? DB * HEADS : 0);
    for (int idx = gw; idx < total; idx += NGW) {
        const bool prm = idx < n_prompt;
        int b, h, c, item;
        if (prm) { const int bh = idx / nc; c = c_lo + (idx - bh * nc); b = bh >> 2; h = bh & 3; item = bh * 33 + c; } else { const int i = idx - n_prompt; b = i >> 2; h = i & 3; c = 0; item = N_ITEMS_P + i; }
        if (prm && c == 0 && b != 0) continue;
        const int cbase = GLA_CBASE(prm, b, c);
        if (prm && c == 0) gla_qk_item<48>(PROJ, ALRF, EXPBL, w2, b_alpha, La, Ls, lane, item, cbase, h);
        else gla_qk_item<0>(PROJ, ALRF, EXPBL, w2, b_alpha, La, Ls, lane, item, cbase, h);
    }
}

constexpr int PL_WP = 0;
constexpr int PL_MIX = 65536;
__device__ __forceinline__ void unpack8(const v4u w, f32x4& lo, f32x4& hi) { lo = (f32x4){bflo(w[0]), bfhi(w[0]), bflo(w[1]), bfhi(w[1])}; hi = (f32x4){bflo(w[2]), bfhi(w[2]), bflo(w[3]), bfhi(w[3])}; }
template <int WIN>
__device__ __forceinline__ void gla_pool_units(Frame& F, bf16* PROJ, float* outp, LAS unsigned char* L, const unsigned lane, const int h, const int t_lo, const int t_hi, const bool with_sample, const int hw, const int NHW) {
    constexpr float rwin = 1.0f / (float)WIN;
    constexpr unsigned PHOFF = (unsigned)MIN_ROWS * NPROJ;
    LAS unsigned char* Lm = L + PL_MIX + F.wave * 4096;
    const int nt = t_hi - t_lo, n_prompt = NB * nt, total = n_prompt + (with_sample ? DB * 4 : 0);
    for (int u = hw; u < total; u += NHW) {
        unsigned lz = lane; asm volatile("" : "+v"(lz));
        const bool prm = u < n_prompt; int b, tile;
        if (prm) { b = u / nt; tile = t_lo + (u - b * nt); } else { const int su = u - n_prompt; b = su >> 2; tile = su & 3; }
        const int t0 = 16 * tile;
        const unsigned row0 = prm ? b * SEQ : MP + b * DSEQ;
        const bool last = prm ? tile == 127 : tile == 3;
        {
            const int o = lz & 15, rq = lz >> 4; const int tb = t0 + 4 * rq;
            const unsigned curoff = row0 * NPROJ + C_P + h * PG + 8 * o;
            const unsigned negoff = prm ? (unsigned)(ROW_META + 16) * NPROJ + C_P + h * PG + 8 * o : PHOFF + (unsigned)(b * PBUF + PBUF) * PW + h * PG + 8 * o;
            const unsigned dneg = negoff - curoff; const int dpitch = prm ? 0 : PW - NPROJ;
#define POOL_ROW(tq) (*(const v4u*)(PROJ + (curoff + (unsigned)((tq) * NPROJ) + ((unsigned)((tq) >> 31) & (dneg + (unsigned)((tq) * dpitch))))))
            f32x4 s0 = {0.f, 0.f, 0.f, 0.f}, s1 = s0, c0[4], c1[4];
            v4u wn[4], wo[3];
#pragma unroll
            for (int i = 0; i < 4; ++i) wn[i] = POOL_ROW(tb + i);
#pragma unroll
            for (int i = 0; i < 3; ++i) wo[i] = POOL_ROW(tb + 1 + i - WIN);
#pragma unroll
            for (int j0 = 1; j0 < WIN; j0 += 8) { v4u pw[8];
#pragma unroll
                for (int jj = 0; jj < 8; ++jj) if (j0 + jj < WIN) pw[jj] = POOL_ROW(tb - (j0 + jj));
#pragma unroll
                for (int jj = 0; jj < 8; ++jj) if (j0 + jj < WIN) { f32x4 lo, hi; unpack8(pw[jj], lo, hi); s0 += lo; s1 += hi; } }
#pragma unroll
            for (int i = 0; i < 4; ++i) { unpack8(wn[i], c0[i], c1[i]); s0 += c0[i]; s1 += c1[i];
                if (i > 0) { f32x4 lo, hi; unpack8(wo[i - 1], lo, hi); s0 -= lo; s1 -= hi; }
                const f32x4 m0 = s0 * rwin - c0[i], m1 = s1 * rwin - c1[i];
                *(LAS v4u*)(Lm + off_b(4 * rq + i, o)) = (v4u){pkbf(m0[0], m0[1]), pkbf(m0[2], m0[3]), pkbf(m1[0], m1[1]), pkbf(m1[2], m1[3])};
                if (last && (4 * rq + i) >= 1) { float* po = outp + (prm ? OFF_SPP : OFF_SPS) + (size_t)(b * PBUF + (4 * rq + i - 1)) * PW + h * PG + 8 * o; *(f32x4*)po = c0[i]; *(f32x4*)(po + 4) = c1[i]; } }
#undef POOL_ROW
        }
        asm volatile("s_waitcnt lgkmcnt(0)" ::: "memory");
        const int l15 = lz & 15, g = lz >> 4;
        unsigned aks[4];
#pragma unroll
        for (int ks = 0; ks < 4; ++ks) aks[ks] = 256u * l15 + 16u * (g ^ ((l15 >> 2) & 3)) + 64u * (ks ^ (l15 & 3));
        bf16x8 mixf[4];
#pragma unroll
        for (int ks = 0; ks < 4; ++ks) mixf[ks] = *(const LAS bf16x8*)(Lm + aks[ks]);
        const unsigned gboff = (row0 + (unsigned)(t0 + l15)) * NPROJ + C_GB + h * DVH + 8 * g;
#pragma unroll
        for (int half = 0; half < 2; ++half) {
            v4u gbw[4];
#pragma unroll
            for (int dp = 0; dp < 4; ++dp) gbw[dp] = *(const v4u*)(PROJ + (gboff + 32u * (4 * half + dp)));
            f32x4 y[8];
#pragma unroll
            for (int d = 0; d < 8; ++d) { y[d] = (f32x4){0.f, 0.f, 0.f, 0.f};
#pragma unroll
                for (int ks = 0; ks < 4; ++ks) y[d] = MFMA16(*(const LAS bf16x8*)(L + PL_WP + aks[ks] + 4096 * (8 * half + d)), mixf[ks], y[d]); }
#pragma unroll
            for (int dp = 0; dp < 4; ++dp) { v4u ow;
#pragma unroll
                for (int hh = 0; hh < 2; ++hh) { const f32x4 yy = y[2 * dp + hh]; const unsigned w0 = gbw[dp][2 * hh], w1 = gbw[dp][2 * hh + 1];
                    ow[2 * hh] = pkbf(bflo(w0) * yy[0], bfhi(w0) * yy[1]); ow[2 * hh + 1] = pkbf(bflo(w1) * yy[2], bfhi(w1) * yy[3]); }
                *(v4u*)(PROJ + (gboff + 32u * (4 * half + dp))) = ow; }
            asm volatile("" ::: "memory");
        }
        asm volatile("s_waitcnt lgkmcnt(0)" ::: "memory");
    }
}
__device__ __forceinline__ void gla_prep_pool(Frame& F, const int t_lo, const int t_hi, const bool with_sample, const int idx, const int n) {
    unsigned char* ws = KWS(); float* outp = KOUT();
    bf16* PROJ = (bf16*)(ws + WS_PROJ); const bf16* WPT = (const bf16*)(ws + WS_WPT);
    LAS unsigned char* L = F.lds;
    int tid_ = F.tid; asm volatile("" : "+v"(tid_));
    const int tid = tid_; const unsigned lane = (unsigned)tid & 63u;
    const int b1 = (n * 13) >> 6, b2 = (n * 55) >> 7, b3 = (n * 44) >> 6;
    const int h = idx < b1 ? 0 : idx < b2 ? 1 : idx < b3 ? 2 : 3;
    const int wgi = idx - (h == 0 ? 0 : h == 1 ? b1 : h == 2 ? b2 : b3), nwgh = (h == 0 ? b1 : h == 1 ? b2 - b1 : h == 2 ? b3 - b2 : n - b3);
    const int hw = F.wave * nwgh + wgi, NHW = nwgh * NWAVES;
    __syncthreads();
    { const bf16* wph = WPT + (size_t)h * DVH * PG;
#pragma unroll
      for (int q = 0; q < 8; ++q) { const unsigned i = (unsigned)tid + 512u * q, row = i >> 4, ch = i & 15u;
          const unsigned srow = 32u * (row >> 5) + 8u * ((row >> 2) & 3u) + 4u * ((row >> 4) & 1u) + (row & 3u);
          *(LAS v4u*)(L + PL_WP + off_b(row, ch)) = *(const v4u*)(wph + srow * PG + 8u * ch); } }
    __syncthreads();
    if (h == 0) gla_pool_units<2>(F, PROJ, outp, L, lane, h, t_lo, t_hi, with_sample, hw, NHW);
    else if (h == 1) gla_pool_units<4>(F, PROJ, outp, L, lane, h, t_lo, t_hi, with_sample, hw, NHW);
    else if (h == 2) gla_pool_units<8>(F, PROJ, outp, L, lane, h, t_lo, t_hi, with_sample, hw, NHW);
    else gla_pool_units<16>(F, PROJ, outp, L, lane, h, t_lo, t_hi, with_sample, hw, NHW);
    __syncthreads();
}

__device__ __forceinline__ void dma16(const void* gsrc, unsigned lds_dst) {
    unsigned keep;
    asm volatile("s_mov_b32 %0, m0\n\ts_mov_b32 m0, %2\n\ts_nop 0\n\tglobal_load_lds_dwordx4 %1, off\n\ts_mov_b32 m0, %0" : "=&s"(keep) : "v"(gsrc), "s"(lds_dst) : "memory");
}
constexpr int SC_BUF = 66560, SC_QT = 0, SC_KT = 16384, SC_V = 32768, SC_EX = 65536, SC_AT = 2 * SC_BUF, SC_RS = SC_AT + 9216, SC_END = SC_RS + 2 * 2048;
constexpr int AT_PITCH = 144;
static_assert(SC_END <= LDSCTL_OFF, "scan LDS map");
__device__ __forceinline__ void gla_scan(Frame& F, const int K0) {
    unsigned char* ws = KWS(); const float* st_gla = KIN(2); float* outp = KOUT();
    const bf16* ZPAGE = (const bf16*)(ws + WS_WIN) + (size_t)(5632 + 16) * D;
    const bf16* PROJ = (const bf16*)(ws + WS_PROJ); const float* EXPBL = (const float*)(ws + WS_EXPBL); bf16* MERGED = (bf16*)(ws + WS_MERGED);
    LAS unsigned char* L = F.lds; const unsigned lbase = (unsigned)(size_t)L;
    int tid_ = F.tid; asm volatile("" : "+v"(tid_));
    const int tid = tid_; const int w = F.wave;
    for (int u = F.vcu; u < 192; u += F.G) {
        const bool prm = u < 128; const int b = prm ? (u >> 2) : ((u - 128) >> 2), h = u & 3;
        int tu = tid; asm volatile("" : "+v"(tu));
        f32x4 S[8][2];
        { const unsigned l15u = tu & 15, gu = (tu >> 4) & 3; const float* s0h = st_gla + (size_t)(b * HEADS + h) * DKH * DVH + 32 * w;
#pragma unroll
          for (int kt = 0; kt < 8; ++kt)
#pragma unroll
            for (int dt = 0; dt < 2; ++dt) {
                if (prm) S[kt][dt] = (f32x4){0.f, 0.f, 0.f, 0.f};
                else { const unsigned o0 = (16u * kt + 4u * gu) * DVH + 8u * (l15u >> 2) + 4u * dt + (l15u & 3u); S[kt][dt] = (f32x4){s0h[o0], s0h[o0 + DVH], s0h[o0 + 2 * DVH], s0h[o0 + 3 * DVH]}; }
            } }
#define SCAN_ISSUE(cc, tm, tz, bf) do { const int cb_ = GLA_CBASE(prm, b, cc); const bf16* crow_ = PROJ + (size_t)cb_ * NPROJ + h * DVH; const bf16* crowk_ = PROJ + (size_t)cb_ * NPROJ + h * DKH; \
            const unsigned l_ = (unsigned)(tz) & 63u; const unsigned Lb_ = lbase + (unsigned)((bf) * SC_BUF); \
            _Pragma("unroll") for (int q = 0; q < 2; ++q) { const unsigned s = 4u * (q * 8u + w) + (l_ >> 4), ch = (l_ & 15u) ^ (((s & 3u) << 2) | ((s >> 2) & 3u)); const bool ok = (int)s >= (tm); \
                const bf16* srcq = ok ? crowk_ + (s * NPROJ + C_Q + 8u * ch) : ZPAGE + 8u * l_; const bf16* srck = ok ? crowk_ + (s * NPROJ + C_K + 8u * ch) : ZPAGE + 8u * l_; \
                dma16(srcq, Lb_ + SC_QT + (q * 8 + w) * 1024); dma16(srck, Lb_ + SC_KT + (q * 8 + w) * 1024); \
                _Pragma("unroll") for (int hf = 0; hf < 2; ++hf) { const bf16* srcv = ok ? crow_ + (s * NPROJ + C_V + hf * 128u + 8u * ch) : ZPAGE + 8u * l_; \
                    dma16(srcv, Lb_ + SC_V + hf * 16384 + (q * 8 + w) * 1024); } } \
            if (w == 0) { const int it_ = prm ? (((cc) == 0 ? 0 : b) * HEADS + h) * 33 + (cc) : N_ITEMS_P + b * HEADS + h; \
                dma16(EXPBL + (size_t)it_ * 128 + 4u * (l_ & 31u), Lb_ + SC_EX); } } while (0)
#pragma unroll
        for (int kt = 0; kt < 8; ++kt) asm volatile("" : "+v"(S[kt][0]), "+v"(S[kt][1]));
        __syncthreads();
        SCAN_ISSUE(0, (prm ? 48 : 0), tu, 0);
        asm volatile("s_waitcnt vmcnt(0)" ::: "memory");
        __syncthreads();
        const int nchunk = prm ? 33 : 1;
        for (int c2 = 0; c2 < nchunk; c2 += 2) {
#pragma unroll
          for (int par = 0; par < 2; ++par) {
            const int c = c2 + par; if (c >= nchunk) break;
            const int cbase = GLA_CBASE(prm, b, c);
            const bool emit = !(prm && c == 0);
            int tc = tid; asm volatile("" : "+v"(tc));
            const unsigned lane = (unsigned)tc & 63u; const int l15 = lane & 15, g = lane >> 4;
            const unsigned c2_ = ((unsigned)l15 >> 2) & 3u, l3_ = (unsigned)l15 & 3u, gh_ = (unsigned)g >> 1, g8_ = 8u * ((unsigned)g & 1u);
            const unsigned RB = 256u * l15 + 16u * ((unsigned)g ^ c2_);
            const unsigned Q0 = 256u * l15 + 16u * (gh_ ^ c2_) + g8_, Q1 = 256u * l15 + 16u * ((gh_ | 2u) ^ c2_) + g8_;
            unsigned xk[4];
#pragma unroll
            for (int ks = 0; ks < 4; ++ks) xk[ks] = 64u * ((unsigned)ks ^ l3_);
            const unsigned tq_ = (unsigned)l15 >> 2, tp_ = l3_;
            const unsigned s0_ = (tq_ << 2) | ((2u * g) & 3u), s1_ = (tq_ << 2) | ((2u * g + 1u) & 3u);
            const unsigned u0 = s0_ >> 1, u1 = s1_ >> 1;
            const unsigned T0 = 256u * (8u * g + tq_) + 8u * (tp_ & 1u) + 16u * ((tp_ >> 1) ^ (s0_ & 1u)), T1 = 256u * (8u * g + tq_ + 4u) + 8u * (tp_ & 1u) + 16u * ((tp_ >> 1) ^ (s1_ & 1u));
#define SC_ROWF(img, rb, ks) (*(const LAS bf16x8*)((img) + (RB + 4096u * (rb) + xk[ks])))
#define SC_TRF(img, cc, ks) __builtin_shufflevector(__builtin_amdgcn_ds_read_tr16_b64_v4i16((LAS s16x4*)((img) + (T0 + 8192u * (ks) + 32u * ((unsigned)(cc) ^ u0)))), \
                                                    __builtin_amdgcn_ds_read_tr16_b64_v4i16((LAS s16x4*)((img) + (T1 + 8192u * (ks) + 32u * ((unsigned)(cc) ^ u1)))), 0, 1, 2, 3, 4, 5, 6, 7)
            LAS unsigned char* Lb = L + par * SC_BUF;
            if (prm && K0 < 33 && c == K0 - 1) {
                if (tid == 0) { unsigned* cl = (unsigned*)(F.ctl + CW_LATE); unsigned sp = 0u;
                    while (__hip_atomic_load(cl, __ATOMIC_RELAXED, __HIP_MEMORY_SCOPE_AGENT) < (unsigned)N_HELP) { __builtin_amdgcn_s_sleep(4); if (++sp > (1u << 22)) break; }
                    __builtin_amdgcn_fence(__ATOMIC_ACQUIRE, "agent"); asm volatile("s_waitcnt vmcnt(0)" ::: "memory"); }
                asm volatile("s_waitcnt lgkmcnt(0)" ::: "memory"); __builtin_amdgcn_s_barrier(); asm volatile("" ::: "memory"); }
            v4u gA[4], gB[4];
            if (emit) { const bf16* crow = PROJ + (size_t)cbase * NPROJ + h * DVH;
#pragma unroll
                for (int tt = 0; tt < 4; ++tt)
                    { const unsigned po = (unsigned)(16 * tt + l15) * NPROJ + 32u * w + 8u * g; gA[tt] = *(const v4u*)(crow + (po + C_GA)); gB[tt] = *(const v4u*)(crow + (po + C_GB)); } }
            { const int cn = (c + 1 < nchunk) ? c + 1 : c; SCAN_ISSUE(cn, 0, tc, (par ^ 1)); }
            {
                const int st = w & 3;
#pragma unroll
                for (int tq = 0; tq < 2; ++tq) { const int tt = 2 * (w >> 2) + tq; f32x4 acc = {0.f, 0.f, 0.f, 0.f};
#pragma unroll
                    for (int ks = 0; ks < 4; ++ks) acc = MFMA16(SC_ROWF(Lb + SC_KT, st, ks), SC_ROWF(Lb + SC_QT, tt, ks), acc);
                    const int tabs = 16 * tt + l15, sabs = 16 * st + 4 * g;
                    float m[4];
#pragma unroll
                    for (int e = 0; e < 4; ++e) m[e] = (sabs + e <= tabs) ? acc[e] : 0.f;
                    *(LAS u32x2*)(L + SC_AT + AT_PITCH * tabs + 2 * sabs) = (u32x2){pkbf(m[0], m[1]), pkbf(m[2], m[3])}; }
            }
            bf16x8 vf[2][2];
#pragma unroll
            for (int dt = 0; dt < 2; ++dt)
#pragma unroll
                for (int ks = 0; ks < 2; ++ks) vf[dt][ks] = SC_TRF(Lb + SC_V + (w >> 2) * 16384, 2 * (w & 3) + dt, ks);
            f32x4 o[2][4];
#pragma unroll
            for (int dt = 0; dt < 2; ++dt)
#pragma unroll
                for (int tt = 0; tt < 4; ++tt) o[dt][tt] = (f32x4){0.f, 0.f, 0.f, 0.f};
#pragma unroll
            for (int ks = 0; ks < 4; ++ks) {
                bf16x8 sa[2];
#pragma unroll
                for (int dt = 0; dt < 2; ++dt) { const f32x4 s0 = S[2 * ks][dt], s1 = S[2 * ks + 1][dt];
                    const v4u pk = {pkbf(s0[0], s0[1]), pkbf(s0[2], s0[3]), pkbf(s1[0], s1[1]), pkbf(s1[2], s1[3])}; sa[dt] = __builtin_bit_cast(bf16x8, pk); }
#pragma unroll
                for (int tt = 0; tt < 4; ++tt) { const unsigned t = 16 * tt + l15;
                    const u32x2 lo = *(const LAS u32x2*)(Lb + SC_QT + (Q0 + 4096u * tt + xk[ks])), hi = *(const LAS u32x2*)(Lb + SC_QT + (Q1 + 4096u * tt + xk[ks]));
                    const v4u bq4 = {lo[0], lo[1], hi[0], hi[1]}; const bf16x8 bq = __builtin_bit_cast(bf16x8, bq4);
#pragma unroll
                    for (int dt = 0; dt < 2; ++dt) o[dt][tt] = MFMA16(sa[dt], bq, o[dt][tt]); }
            }
#pragma unroll
            for (int kt = 0; kt < 8; ++kt) {
#pragma unroll
                for (int ks = 0; ks < 2; ++ks) { const bf16x8 ka = SC_TRF(Lb + SC_KT, kt, ks);
#pragma unroll
                    for (int dt = 0; dt < 2; ++dt) S[kt][dt] = MFMA16(ka, vf[dt][ks], S[kt][dt]); }
                const f32x4 e4 = *(const LAS f32x4*)(Lb + SC_EX + (16 * kt + 4 * g) * 4);
#pragma unroll
                for (int dt = 0; dt < 2; ++dt) S[kt][dt] = S[kt][dt] * e4; }
            asm volatile("s_waitcnt lgkmcnt(0)" ::: "memory"); __builtin_amdgcn_s_barrier(); asm volatile("" ::: "memory");
#pragma unroll
            for (int ks = 0; ks < 2; ++ks)
#pragma unroll
                for (int tt = 0; tt < 4; ++tt) { const bf16x8 ba = *(const LAS bf16x8*)(L + SC_AT + AT_PITCH * (16 * tt + l15) + 64 * ks + 16 * g);
#pragma unroll
                    for (int dt = 0; dt < 2; ++dt) o[dt][tt] = MFMA16(vf[dt][ks], ba, o[dt][tt]); }
#pragma unroll
            for (int tt = 0; tt < 4; ++tt) { float ss = pg8::dot4(o[0][tt]) + pg8::dot4(o[1][tt]); ss += __shfl_xor(ss, 16); ss += __shfl_xor(ss, 32);
                if (g == 0) ((LAS float*)(L + SC_RS + par * 2048))[(16 * tt + l15) * 8 + w] = ss; }
            asm volatile("s_waitcnt vmcnt(0) lgkmcnt(0)" ::: "memory"); __builtin_amdgcn_s_barrier(); asm volatile("" ::: "memory");
            if (emit) {
                bf16* mrow = MERGED + (size_t)cbase * D + h * DVH;
#pragma unroll
                for (int tt = 0; tt < 4; ++tt) asm volatile("" : "+v"(gA[tt]), "+v"(gB[tt]));
#pragma unroll
                for (int tt = 0; tt < 4; ++tt) { const int t = 16 * tt + l15;
                    const f32x4 r0 = *(const LAS f32x4*)(L + SC_RS + par * 2048 + t * 32), r1 = *(const LAS f32x4*)(L + SC_RS + par * 2048 + t * 32 + 16);
                    const float rstd = 1.0f / sqrtf((((r0[0] + r0[1]) + (r0[2] + r0[3])) + ((r1[0] + r1[1]) + (r1[2] + r1[3]))) * (1.0f / 256.0f) + 1e-6f);
                    v4u mw;
#pragma unroll
                    for (int dt = 0; dt < 2; ++dt) {
                        float mv[4];
#pragma unroll
                        for (int e = 0; e < 4; ++e) { const unsigned wa = gA[tt][2 * dt + (e >> 1)], wb_ = gB[tt][2 * dt + (e >> 1)];
                            const float ga = (e & 1) ? bfhi(wa) : bflo(wa), mb = (e & 1) ? bfhi(wb_) : bflo(wb_);
                            mv[e] = ga * (o[dt][tt][e] * rstd) + mb; }
                        mw[2 * dt] = pkbf(mv[0], mv[1]); mw[2 * dt + 1] = pkbf(mv[2], mv[3]); }
                    *(v4u*)(mrow + ((unsigned)t * D + 32u * w + 8u * g)) = mw; }
            }
          }
        }
#undef SCAN_ISSUE
#undef SC_ROWF
#undef SC_TRF
        int to = tid; asm volatile("" : "+v"(to));
        { const unsigned l15u = to & 15, gu = (to >> 4) & 3; float* soh = outp + (prm ? OFF_SGP : OFF_SGS) + (size_t)(b * HEADS + h) * DKH * DVH + 32 * w;
#pragma unroll
          for (int kt = 0; kt < 8; ++kt)
#pragma unroll
            for (int dt = 0; dt < 2; ++dt) { const unsigned o0 = (16u * kt + 4u * gu) * DVH + 8u * (l15u >> 2) + 4u * dt + (l15u & 3u);
                soh[o0] = S[kt][dt][0]; soh[o0 + DVH] = S[kt][dt][1]; soh[o0 + 2 * DVH] = S[kt][dt][2]; soh[o0 + 3 * DVH] = S[kt][dt][3]; } }
    }
    __syncthreads();
}

__device__ __forceinline__ void final_norm_phase(Frame& F, const int row_lo, const int row_hi, const int gw, const int NGW, const bf16* h2base) {
    unsigned char* ws_ = KWS(); float* outp = KOUT();
    int ln = F.lane; asm volatile("" : "+v"(ln));
    const float* SS = (const float*)(ws_ + WS_SS3); const GAS f32x4* gr = (const GAS f32x4*)KIN(17) + 2 * ln;
    f32x4 g[2][2];
#pragma unroll
    for (int j = 0; j < 2; ++j) { g[j][0] = gr[128 * j]; g[j][1] = gr[128 * j + 1]; }
    for (int m0 = row_lo + 2 * gw; m0 < row_hi; m0 += 2 * NGW) {
        v4u hw[2][2]; f32x4 sq[2][4];
#pragma unroll
        for (int r = 0; r < 2; ++r) { const int m = m0 + r;
            const GAS v4u* hr = (const GAS v4u*)(h2base + (size_t)(m - row_lo) * D) + ln;
            hw[r][0] = hr[0]; hw[r][1] = hr[64];
            const f32x4* sp = (const f32x4*)(SS + (size_t)m * 16);
#pragma unroll
            for (int q = 0; q < 4; ++q) sq[r][q] = sp[q]; }
#pragma unroll
        for (int r = 0; r < 2; ++r) { const int m = m0 + r;
            GAS f32x4* xr = (GAS f32x4*)(outp + (size_t)m * D) + 2 * ln;
            const f32x4 s4 = (sq[r][0] + sq[r][1]) + (sq[r][2] + sq[r][3]);
            const float rstd = 1.0f / sqrtf(((s4[0] + s4[1]) + (s4[2] + s4[3])) * (1.0f / 1024.0f) + 1e-6f);
#pragma unroll
            for (int j = 0; j < 2; ++j) { const v4u w_ = hw[r][j];
                const f32x4 v0 = {bflo(w_[0]), bfhi(w_[0]), bflo(w_[1]), bfhi(w_[1])}, v1 = {bflo(w_[2]), bfhi(w_[2]), bflo(w_[3]), bfhi(w_[3])};
                __builtin_nontemporal_store(v0 * rstd * g[j][0], &xr[128 * j]); __builtin_nontemporal_store(v1 * rstd * g[j][1], &xr[128 * j + 1]); } }
    }
}

__device__ __forceinline__ void helper_barrier(gu32* cnt, const unsigned target) {
    asm volatile("s_waitcnt vmcnt(0)" ::: "memory");
    __syncthreads();
    if (threadIdx.x == 0) {
        __builtin_amdgcn_fence(__ATOMIC_RELEASE, "agent");
        asm volatile("s_waitcnt vmcnt(0)" ::: "memory");
        (void)__hip_atomic_fetch_add((unsigned*)cnt, 1u, __ATOMIC_RELAXED, __HIP_MEMORY_SCOPE_AGENT);
        unsigned sp = 0u;
        while (__hip_atomic_load((unsigned*)cnt, __ATOMIC_RELAXED, __HIP_MEMORY_SCOPE_AGENT) < target) { __builtin_amdgcn_s_sleep(2); if (++sp > (1u << 22)) break; }
        __builtin_amdgcn_fence(__ATOMIC_ACQUIRE, "agent");
        asm volatile("s_waitcnt vmcnt(0)" ::: "memory");
    }
    __syncthreads();
}
__device__ __forceinline__ void sample_tail(Frame& F) {
    const int hc = F.vcu - (F.G - N_HELP);
    helper_barrier(F.ctl + CW_HBAR, N_HELP);
    {   unsigned char* ws = KWS();
        pg8::Gemm g{(const pg8::bf16_t*)(ws + WS_MERGED) + (size_t)MP * D, (const pg8::bf16_t*)(ws + WS_WOUT), MS, D, D};
        pg8::StaticOrder S; S.init(MS, D, N_HELP, hc);
        pg8::EpiOut E{KIN(1), KIN(1), 1 << 30, KOUT() + (size_t)MP * D, (pg8::bf16_t*)(ws + WS_HBS), (float*)(ws + WS_SS2) + (size_t)MP * 16};
        pg8::gemm_phase<pg8::EpiOut, pg8::StaticOrder, true, true>(F.lds + RING_OFF, g, S, E);
    }
    helper_barrier(F.ctl + CW_HBAR + 64, N_HELP);
    {   unsigned char* ws = KWS();
        pg8::Gemm g{(const pg8::bf16_t*)(ws + WS_HBS), (const pg8::bf16_t*)(ws + WS_WGU), MS, NGU, D};
        pg8::StaticOrder S; S.init(MS, NGU, N_HELP, hc);
        pg8::EpiGU E{(const float*)(ws + WS_SS2) + (size_t)MP * 16, (pg8::bf16_t*)(ws + WS_ACTS), DFF, 0};
        pg8::gemm_phase<pg8::EpiGU, pg8::StaticOrder, true, true>(F.lds + RING_OFF, g, S, E);
    }
    helper_barrier(F.ctl + CW_HBAR + 128, N_HELP);
    {   unsigned char* ws = KWS();
        pg8::Gemm g{(const pg8::bf16_t*)(ws + WS_ACTS), (const pg8::bf16_t*)(ws + WS_WDN), MS, D, DFF};
        pg8::SplitKOrder S; S.init(MS, D, N_HELP, hc);
        pg8::EpiPart E{(float*)(ws + WS_PART), MS};
        pg8::gemm_phase<pg8::EpiPart, pg8::SplitKOrder, true, true>(F.lds + RING_OFF, g, S, E);
    }
    helper_barrier(F.ctl + CW_HBAR + 192, N_HELP);
    {   unsigned char* ws_ = KWS(); float* outp = KOUT();
        int ln = F.lane; asm volatile("" : "+v"(ln));
        const GAS f32x4* gr = (const GAS f32x4*)KIN(17) + 2 * ln;
        for (int m = hc * NWAVES + F.wave; m < MS; m += N_HELP * NWAVES) {
            const GAS v4u* hr = (const GAS v4u*)((const bf16*)(ws_ + WS_HBS) + (size_t)m * D) + ln;
            f32x4 v[2][2];
#pragma unroll
            for (int j = 0; j < 2; ++j) { const v4u w_ = hr[64 * j];
                v[j][0] = (f32x4){bflo(w_[0]), bfhi(w_[0]), bflo(w_[1]), bfhi(w_[1])}; v[j][1] = (f32x4){bflo(w_[2]), bfhi(w_[2]), bflo(w_[3]), bfhi(w_[3])}; }
#pragma unroll
            for (int q = 0; q < 4; ++q) { const GAS f32x4* pr = (const GAS f32x4*)((const float*)(ws_ + WS_PART) + ((size_t)q * MS + m) * D) + 2 * ln;
#pragma unroll
                for (int j = 0; j < 2; ++j) { v[j][0] += pr[128 * j]; v[j][1] += pr[128 * j + 1]; } }
            float ss = 0.f;
#pragma unroll
            for (int j = 0; j < 2; ++j) ss += pg8::dot4(v[j][0]) + pg8::dot4(v[j][1]);
            const float rstd = 1.0f / sqrtf(wave_sum(ss) * (1.0f / 1024.0f) + 1e-6f);
            GAS f32x4* xr = (GAS f32x4*)(outp + (size_t)(MP + m) * D) + 2 * ln;
#pragma unroll
            for (int j = 0; j < 2; ++j) { xr[128 * j] = v[j][0] * rstd * gr[128 * j]; xr[128 * j + 1] = v[j][1] * rstd * gr[128 * j + 1]; }
        }
    }
}

__device__ __forceinline__ int build_rstd_table(Frame& F, const pg8::StaticOrder& S, const float* SS) {
    LAS float* tab = (LAS float*)(F.lds + TAB_OFF); LAS int* tg = (LAS int*)(tab + 8 * 256);
    __syncthreads();
    if (F.tid < 8) tg[F.tid] = -1;
    __syncthreads();
    int n = 0, lastpm = -1;
    for (int i = 0; ; ++i) { pg8::Unit u; if (!S.next(i, u)) break;
        if (u.pm == lastpm) continue;
        if (n == 8) { n = 9; break; }
        if (F.tid < 256) { const f32x4* sp = (const f32x4*)(SS + (size_t)(u.pm * 256 + F.tid) * 16); const f32x4 s4 = (sp[0] + sp[1]) + (sp[2] + sp[3]);
            tab[n * 256 + F.tid] = __builtin_amdgcn_rsqf(((s4[0] + s4[1]) + (s4[2] + s4[3])) * (1.0f / 1024.0f) + pg8::RMS_EPS); }
        if (F.tid == 0) tg[n] = u.pm;
        ++n; lastpm = u.pm; }
    __syncthreads();
    return n <= 8 ? n : 0;
}

__global__ void __launch_bounds__(NWAVES * 64, 2) fwd_mega(Args args) {
    extern __shared__ __attribute__((aligned(16))) unsigned char lds[];
    Frame F;
    F.lds = (LAS unsigned char*)lds;
    F.MISC = (volatile LAS unsigned*)(F.lds + MISC_OFF);
    F.tid = threadIdx.x; F.lane = F.tid & 63; F.wave = __builtin_amdgcn_readfirstlane(F.tid >> 6);
    F.G = gridDim.x; { const int bx = blockIdx.x; F.vcu = (F.G % 8 == 0) ? (bx % 8) * (F.G / 8) + bx / 8 : bx; }
    F.ctl = (gu32*)(KWS() + WS_CTL);
    for (int u = F.tid; u < (LDS_BYTES - LDSCTL_OFF) / 4; u += NWAVES * 64) ((LAS unsigned*)(F.lds + LDSCTL_OFF))[u] = 0u;
    __syncthreads();
    XcdBarrier bar = xcd_barrier_post((unsigned*)(F.ctl + CW_BAR), F.MISC + 8);
#define GRID_BAR() xcd_barrier(bar)
    p0_prologue(F);
    GRID_BAR();
    {   unsigned char* ws = KWS();
        pg8::Gemm g{(const pg8::bf16_t*)(ws + WS_XN), (const pg8::bf16_t*)(ws + WS_WIN), MIN_ROWS, NIN, D};
        pg8::StaticOrder S; S.init(MIN_ROWS, NIN, F.G, (int)blockIdx.x);
        LAS float* gt = (LAS float*)(F.lds + TAB_OFF);
        { const f32x4 v = (F.tid < 256) ? ((const f32x4*)KIN(9))[F.tid] : ((const f32x4*)KIN(11))[F.tid - 256]; ((LAS f32x4*)gt)[F.tid] = v; }
        __syncthreads();
        pg8::EpiProj E{(pg8::bf16_t*)(ws + WS_PROJ), NPROJ, (float*)(ws + WS_ALR)};
        pg8::gemm_phase<pg8::EpiProj, pg8::StaticOrder, true, true>(F.lds + RING_OFF, g, S, E);
    }
    {
        const int nwg1 = (MIN_ROWS / 256) * (NIN / 256), rem = nwg1 % F.G, c = (int)blockIdx.x;
        const int ne = rem == 0 ? F.G : F.G - rem, e = rem == 0 ? c : c - rem;
        if (e >= 0) late_weight_items(F, e, ne);
    }
    GRID_BAR();
    const bool split = (F.G == 256);
    const int K0 = split ? 21 : 33;
    gla_prep_qk(F, 0, K0, true, F.wave * F.G + F.vcu, F.G * NWAVES);
    gla_prep_pool(F, 0, 4 * (K0 - 1), true, F.vcu, F.G);
    GRID_BAR();
    gla_scan(F, K0);
    if (split && F.vcu >= F.G - N_HELP) {
        const int hc = F.vcu - (F.G - N_HELP);
        gla_prep_qk(F, K0, 33, false, F.wave * N_HELP + hc, N_HELP * NWAVES);
        gla_prep_pool(F, 4 * (K0 - 1), 128, false, hc, N_HELP);
        asm volatile("s_waitcnt vmcnt(0)" ::: "memory");
        __syncthreads();
        if (F.tid == 0) { __builtin_amdgcn_fence(__ATOMIC_RELEASE, "agent"); asm volatile("s_waitcnt vmcnt(0)" ::: "memory"); (void)__hip_atomic_fetch_add((unsigned*)(F.ctl + CW_LATE), 1u, __ATOMIC_RELAXED, __HIP_MEMORY_SCOPE_AGENT); }
    }
    const int MROWS = (F.G == 256) ? MP : MO;
    if (F.G == 256 && F.vcu >= F.G - N_HELP) sample_tail(F);
    GRID_BAR();
    {   unsigned char* ws = KWS();
        pg8::Gemm g{(const pg8::bf16_t*)(ws + WS_MERGED), (const pg8::bf16_t*)(ws + WS_WOUT), MROWS, D, D};
        pg8::StaticOrder S; S.init(MROWS, D, F.G, (int)blockIdx.x);
        pg8::EpiOut E{KIN(0), KIN(1), MP, KOUT(), (pg8::bf16_t*)(ws + WS_HB), (float*)(ws + WS_SS2)};
        pg8::gemm_phase<pg8::EpiOut, pg8::StaticOrder, true, true>(F.lds + RING_OFF, g, S, E);
    }
    GRID_BAR();
    {   unsigned char* ws = KWS();
        pg8::Gemm g{(const pg8::bf16_t*)(ws + WS_HB), (const pg8::bf16_t*)(ws + WS_WGU), MROWS, NGU, D};
        pg8::StaticOrder S; S.init(MROWS, NGU, F.G, (int)blockIdx.x);
        const int ntab = build_rstd_table(F, S, (const float*)(ws + WS_SS2));
        pg8::EpiGU E{(const float*)(ws + WS_SS2), (pg8::bf16_t*)(ws + WS_ACT), DFF, ntab};
        pg8::gemm_phase<pg8::EpiGU, pg8::StaticOrder, true, true>(F.lds + RING_OFF, g, S, E);
    }
    GRID_BAR();
    {   unsigned char* ws = KWS();
        pg8::Gemm g{(const pg8::bf16_t*)(ws + WS_ACT), (const pg8::bf16_t*)(ws + WS_WDN), MROWS, D, DFF};
        pg8::StaticOrder S; S.init(MROWS, D, F.G, (int)blockIdx.x);
        pg8::EpiDown E{(float*)(ws + WS_SS3), (pg8::bf16_t*)(ws + WS_HB)};
        pg8::gemm_phase<pg8::EpiDown, pg8::StaticOrder, true, true>(F.lds + RING_OFF, g, S, E);
    }
    GRID_BAR();
    final_norm_phase(F, 0, MROWS, F.vcu * NWAVES + F.wave, F.G * NWAVES, (const bf16*)(KWS() + WS_HB));
}

extern "C" void kernel_launch(void* const* d_in, const int* in_sizes, int n_in, void* d_out, int out_size, void* d_ws, size_t ws_size, hipStream_t stream) {
    static int grid = 0;
    if (grid == 0) {
        if (n_in != 18 || ws_size < WS_END) { fprintf(stderr, "kernel_launch: needs 18 inputs and >= %zu bytes of workspace; got n_in %d, ws %zu; nothing launched\n", (size_t)WS_END, n_in, ws_size); grid = -1; return; }
        int dev = 0, cus = 0, per_cu = 0;
        if (hipGetDevice(&dev) != hipSuccess || hipDeviceGetAttribute(&cus, hipDeviceAttributeMultiprocessorCount, dev) != hipSuccess) { grid = -1; return; }
        if (hipFuncSetAttribute((const void*)fwd_mega, hipFuncAttributeMaxDynamicSharedMemorySize, LDS_BYTES) != hipSuccess) { fprintf(stderr, "kernel_launch: hipFuncSetAttribute failed\n"); grid = -1; return; }
        if (hipOccupancyMaxActiveBlocksPerMultiprocessor(&per_cu, (const void*)fwd_mega, NWAVES * 64, LDS_BYTES) != hipSuccess || per_cu < 1) { fprintf(stderr, "kernel_launch: occupancy query reports %d\n", per_cu); }
        (void)hipGetLastError();
        grid = cus;
    }
    if (grid < 0) return;
    if (hipMemsetAsync((char*)d_ws + WS_CTL, 0, CTL_ZERO_BYTES, stream) != hipSuccess) { fprintf(stderr, "kernel_launch: memset failed\n"); return; }
    Args a{};
    for (int i = 0; i < 18; ++i) a.in[i] = (const float*)d_in[i];
    a.out = (float*)d_out; a.ws = (unsigned char*)d_ws;
    hipLaunchKernelGGL(fwd_mega, dim3(grid), dim3(NWAVES * 64), LDS_BYTES, stream, a);
}
```

```cpp
#include <hip/hip_runtime.h>
#include <cstdio>
#include <cstdint>
namespace pg8 {
#define PG8_LAS __attribute__((address_space(3)))
typedef unsigned short bf16_t;
typedef short bf16x8 __attribute__((ext_vector_type(8)));
typedef float f32x4 __attribute__((ext_vector_type(4)));
typedef unsigned u32x4 __attribute__((ext_vector_type(4)));
constexpr int BM = 256, BK = 64, HALF = 128, HTB = HALF * BK * 2  , STAGE_BYTES = 8 * HTB, NXCD = 8, WGM = 4;

__host__ __device__ __forceinline__ int lds_byte(int r, int c) { const int st = (r >> 4) * 2 + (c >> 5), rr = r & 15, cc = c & 31, ob = rr * 64 + cc * 2; return st * 1024 + (ob ^ (((ob >> 9) & 1) << 5)); }
__host__ __device__ __forceinline__ void stage_rc(int b, int& R, int& C) { const int st = b / 1024, sb = b % 1024, swz = sb ^ (((sb >> 9) & 1) << 5); R = (st >> 1) * 16 + swz / 64; C = (st & 1) * 32 + (swz % 64) / 2; }
__host__ __device__ __forceinline__ int perm32(int rho) { const int n = rho >> 4, i = rho & 15; return 8 * (i >> 2) + 4 * n + (i & 3); }

struct Unit { int pm, pn, k0, nkt, ks; };
struct Gemm { const bf16_t* A; const bf16_t* Bt; int M, N, K; };

struct StaticOrder {
    static constexpr bool SPLITK = false;
    int nM, nN, nwg, G, c;
    __host__ __device__ void init(int M, int N, int G_, int c_) { nM = M / BM; nN = N / BM; nwg = nM * nN; G = G_; c = c_; }
    __host__ __device__ bool next(int i, Unit& u) const {
        const long L = (long)i * G + c; if (L >= nwg) return false;
        int wgid = (int)L; { const int q = nwg / NXCD, r = nwg % NXCD, xcd = wgid % NXCD, off = wgid / NXCD; wgid = (xcd < r ? xcd * (q + 1) : r * (q + 1) + (xcd - r) * q) + off; }
        const int nig = WGM * nN, gid = wgid / nig, fm = gid * WGM, gsz = (nM - fm) < WGM ? (nM - fm) : WGM;
        u.pm = fm + ((wgid % nig) % gsz); u.pn = (wgid % nig) / gsz; return true;
    }
    __device__ __forceinline__ void a_ready(const Unit&) const {}
    __device__ __forceinline__ void done(const Unit&) const {}
};

struct SplitKOrder {
    static constexpr bool SPLITK = true;
    int nM, nN, total, G, c;
    __host__ __device__ void init(int M, int N, int G_, int c_) { nM = M / BM; nN = N / BM; total = nM * nN * 4; G = G_; c = c_; }
    __host__ __device__ bool next(int i, Unit& u) const {
        const long L = (long)i * G + c; if (L >= total) return false;
        const int tile = (int)L >> 2, ks = (int)L & 3;
        u.pm = tile % nM; u.pn = tile / nM; u.ks = ks; u.k0 = ks < 2 ? 12 * ks : 24 + 10 * (ks - 2); u.nkt = ks < 2 ? 12 : 10; return true;
    }
    __device__ __forceinline__ void a_ready(const Unit&) const {}
    __device__ __forceinline__ void done(const Unit&) const {}
};

__device__ __forceinline__ unsigned cvt_pk_bf16(float lo, float hi) { unsigned r; asm volatile("v_cvt_pk_bf16_f32 %0, %1, %2" : "=v"(r) : "v"(lo), "v"(hi)); return r; }
typedef float f32x2 __attribute__((ext_vector_type(2)));
typedef unsigned u32x2 __attribute__((ext_vector_type(2)));
constexpr float RMS_EPS = 1e-6f;
__device__ __forceinline__ float fast_exp(float x) { return __builtin_amdgcn_exp2f(x * 1.44269504089f); }
__device__ __forceinline__ float fast_sigmoid(float x) { return __builtin_amdgcn_rcpf(1.0f + fast_exp(-x)); }
__device__ __forceinline__ float dot4(const f32x4 a) { return (a[0] * a[0] + a[1] * a[1]) + (a[2] * a[2] + a[3] * a[3]); }
__device__ __forceinline__ u32x4 pack8(const f32x4 v0, const f32x4 v1) { u32x4 w; w.x = cvt_pk_bf16(v0[0], v0[1]); w.y = cvt_pk_bf16(v0[2], v0[3]); w.z = cvt_pk_bf16(v1[0], v1[1]); w.w = cvt_pk_bf16(v1[2], v1[3]); return w; }

struct EpiProj {
    static constexpr bool PERM = true, AFTER_DRAIN = false;
    bf16_t* O; int ldc; float* ALR;
    __device__ __forceinline__ void operator()(const f32x4 (&acc)[2][2][4][2], const Unit& u, int wr, int wc, int fr, int fq, const PG8_LAS unsigned char* side) const {
        bf16_t* tb = O + (size_t)(u.pm * BM) * ldc;
        unsigned off = (unsigned)(wr * 64 + fr) * (unsigned)ldc + (unsigned)(wc * 32 + 8 * fq);
        if (u.pn == 22) {
            if (wc == 0 && fq < 2) {
#pragma unroll
                for (int ai = 0; ai < 2; ++ai)
#pragma unroll
                    for (int m = 0; m < 4; ++m) { float* ap = ALR + (size_t)(u.pm * BM + wr * 64 + fr + ai * HALF + m * 16) * 16 + 8 * fq; *(f32x4*)ap = acc[ai][0][m][0]; *(f32x4*)(ap + 4) = acc[ai][0][m][1]; }
            }
        } else if (u.pn < 10) {
            off += (unsigned)(u.pn * BM);
#pragma unroll
            for (int ai = 0; ai < 2; ++ai)
#pragma unroll
                for (int m = 0; m < 4; ++m) { asm volatile("" : "+v"(off));
#pragma unroll
                    for (int bj = 0; bj < 2; ++bj) __builtin_nontemporal_store(pack8(acc[ai][bj][m][0], acc[ai][bj][m][1]), (u32x4*)(tb + (off + bj * HALF)));
                    off += (m == 3 ? 80u : 16u) * (unsigned)ldc; }
        } else if (u.pn < 18) {
            const int cl = (u.pn - 10) * HALF + wc * 32 + 8 * fq;
            const f32x4 g0 = *(const PG8_LAS f32x4*)(side + 4 * cl), g1 = *(const PG8_LAS f32x4*)(side + 4 * cl + 16);
            off += 2560u + (unsigned)((u.pn - 10) * HALF);
#pragma unroll
            for (int ai = 0; ai < 2; ++ai)
#pragma unroll
                for (int m = 0; m < 4; ++m) { f32x4 rr0 = acc[ai][0][m][0], rr1 = acc[ai][0][m][1], qq0 = acc[ai][1][m][0], qq1 = acc[ai][1][m][1];
                    asm volatile("" : "+v"(off), "+v"(rr0), "+v"(rr1), "+v"(qq0), "+v"(qq1));
                    f32x4 a[2];
#pragma unroll
                    for (int j = 0; j < 4; ++j) { const float r0 = rr0[j], r1 = rr1[j];
                        a[0][j] = r0 * g0[j] * __builtin_amdgcn_rcpf((1.0f + fast_exp(-r0)) * (1.0f + fast_exp(-qq0[j]))); a[1][j] = r1 * g1[j] * __builtin_amdgcn_rcpf((1.0f + fast_exp(-r1)) * (1.0f + fast_exp(-qq1[j]))); }
                    __builtin_nontemporal_store(pack8(a[0], a[1]), (u32x4*)(tb + off)); off += (m == 3 ? 80u : 16u) * (unsigned)ldc; __builtin_amdgcn_sched_barrier(0); }
        } else {
            const int cl = (u.pn - 18) * BM + wc * 32 + 8 * fq;
            off += 3584u + (unsigned)((u.pn - 18) * BM);
            const PG8_LAS unsigned char* ps = side + 4096 + 4 * cl;
            const f32x4 p00 = *(const PG8_LAS f32x4*)(ps), p01 = *(const PG8_LAS f32x4*)(ps + 16), p10 = *(const PG8_LAS f32x4*)(ps + 4 * HALF), p11 = *(const PG8_LAS f32x4*)(ps + 4 * HALF + 16);
#pragma unroll
            for (int ai = 0; ai < 2; ++ai)
#pragma unroll
                for (int m = 0; m < 4; ++m) { f32x4 x00 = acc[ai][0][m][0], x01 = acc[ai][0][m][1], x10 = acc[ai][1][m][0], x11 = acc[ai][1][m][1];
                    asm volatile("" : "+v"(off), "+v"(x00), "+v"(x01), "+v"(x10), "+v"(x11));
#pragma unroll
                    for (int bj = 0; bj < 2; ++bj) { f32x4 a[2];
#pragma unroll
                        for (int j = 0; j < 4; ++j) { a[0][j] = fast_sigmoid(bj ? x10[j] : x00[j]) * (bj ? p10[j] : p00[j]); a[1][j] = fast_sigmoid(bj ? x11[j] : x01[j]) * (bj ? p11[j] : p01[j]); }
                        __builtin_nontemporal_store(pack8(a[0], a[1]), (u32x4*)(tb + (off + bj * HALF))); }
                    off += (m == 3 ? 80u : 16u) * (unsigned)ldc; __builtin_amdgcn_sched_barrier(0); }
        }
    }
};
struct EpiOut {
    static constexpr bool PERM = true, AFTER_DRAIN = false;
    const float* xp; const float* xs; int n_prompt_rows; float* out; bf16_t* HB; float* SS;
    __device__ __forceinline__ void operator()(const f32x4 (&acc)[2][2][4][2], const Unit& u, int wr, int wc, int fr, int fq, const PG8_LAS unsigned char* side) const {
        const int row0 = u.pm * BM + wr * 64 + fr, col0 = u.pn * BM + wc * 32 + 8 * fq;
        const bool prm = (u.pm * BM) < n_prompt_rows;
#pragma unroll
        for (int ai = 0; ai < 2; ++ai)
#pragma unroll
            for (int m = 0; m < 4; ++m) { const int row = row0 + ai * HALF + m * 16;
                const float* xr = prm ? xp + (size_t)row * 1024 : xs + (size_t)(row - n_prompt_rows) * 1024;
                float ss = 0.f;
#pragma unroll
                for (int bj = 0; bj < 2; ++bj) { const int c = col0 + bj * HALF;
                    const f32x4 h0 = *(const f32x4*)(xr + c) + acc[ai][bj][m][0], h1 = *(const f32x4*)(xr + c + 4) + acc[ai][bj][m][1];
                    *(u32x4*)(HB + (size_t)row * 1024 + c) = pack8(h0, h1);
                    ss += dot4(h0) + dot4(h1); }
                ss += __shfl_xor(ss, 16); ss += __shfl_xor(ss, 32);
                if (fq == 0) SS[(size_t)row * 16 + u.pn * 4 + wc] = ss; }
    }
};
struct EpiGU {
    static constexpr bool PERM = true, AFTER_DRAIN = false;
    const float* SS; bf16_t* ACT; int ldact;
    int ntab;
    __device__ __forceinline__ void operator()(const f32x4 (&acc)[2][2][4][2], const Unit& u, int wr, int wc, int fr, int fq, const PG8_LAS unsigned char* side) const {
        const int row0 = u.pm * BM + wr * 64 + fr, col0 = u.pn * HALF + wc * 32 + 8 * fq;
        if (ntab > 0) {
            const PG8_LAS float* tab = (const PG8_LAS float*)side; const PG8_LAS int* tg = (const PG8_LAS int*)(tab + 8 * 256);
            int slot = 0;
#pragma unroll
            for (int q = 1; q < 8; ++q) if (tg[q] == u.pm) slot = q;
            const PG8_LAS float* tr = tab + slot * 256 + wr * 64 + fr;
#pragma unroll
            for (int ai = 0; ai < 2; ++ai)
#pragma unroll
                for (int m = 0; m < 4; ++m) { const int row = row0 + ai * HALF + m * 16;
                    const float rstd = tr[ai * HALF + m * 16];
                    const f32x2 nrl = {rstd * -1.44269504089f, rstd * -1.44269504089f}, r2 = {rstd * rstd, rstd * rstd}, one = {1.0f, 1.0f};
                    f32x4 a[2];
#pragma unroll
                    for (int n = 0; n < 2; ++n)
#pragma unroll
                        for (int j = 0; j < 4; j += 2) { const f32x2 ag = {acc[ai][0][m][n][j], acc[ai][0][m][n][j + 1]}, au = {acc[ai][1][m][n][j], acc[ai][1][m][n][j + 1]};
                            const f32x2 t = ag * nrl; const f32x2 d = (f32x2){__builtin_amdgcn_exp2f(t[0]), __builtin_amdgcn_exp2f(t[1])} + one;
                            const f32x2 q = {__builtin_amdgcn_rcpf(d[0]), __builtin_amdgcn_rcpf(d[1])}; const f32x2 r = ((ag * au) * r2) * q;
                            a[n][j] = r[0]; a[n][j + 1] = r[1]; }
                    __builtin_nontemporal_store(pack8(a[0], a[1]), (u32x4*)(ACT + (size_t)row * ldact + col0)); }
        } else {
#pragma unroll
            for (int ai = 0; ai < 2; ++ai)
#pragma unroll
                for (int m = 0; m < 4; ++m) { const int row = row0 + ai * HALF + m * 16;
                    const f32x4* sp = (const f32x4*)(SS + (size_t)row * 16);
                    const f32x4 s4 = (sp[0] + sp[1]) + (sp[2] + sp[3]);
                    const float rstd = __builtin_amdgcn_rsqf(((s4[0] + s4[1]) + (s4[2] + s4[3])) * (1.0f / 1024.0f) + RMS_EPS);
                    f32x4 a[2];
#pragma unroll
                    for (int n = 0; n < 2; ++n)
#pragma unroll
                        for (int j = 0; j < 4; ++j) { const float g = acc[ai][0][m][n][j] * rstd, up = acc[ai][1][m][n][j] * rstd; a[n][j] = g * up * fast_sigmoid(g); }
                    __builtin_nontemporal_store(pack8(a[0], a[1]), (u32x4*)(ACT + (size_t)row * ldact + col0)); }
        }
    }
};
struct EpiDown {
    static constexpr bool PERM = true, AFTER_DRAIN = false;
    float* SS; bf16_t* HB;
    __device__ __forceinline__ void operator()(const f32x4 (&acc)[2][2][4][2], const Unit& u, int wr, int wc, int fr, int fq, const PG8_LAS unsigned char* side) const {
        const int row0 = u.pm * BM + wr * 64 + fr, col0 = u.pn * BM + wc * 32 + 8 * fq;
#pragma unroll
        for (int ai = 0; ai < 2; ++ai)
#pragma unroll
            for (int m = 0; m < 4; ++m) { const int row = row0 + ai * HALF + m * 16;
                float ss = 0.f;
#pragma unroll
                for (int bj = 0; bj < 2; ++bj) { bf16_t* hp = HB + (size_t)row * 1024 + col0 + bj * HALF;
                    const u32x4 hw = *(const u32x4*)hp;
                    const f32x4 r0 = {__builtin_bit_cast(float, hw.x << 16), __builtin_bit_cast(float, hw.x & 0xffff0000u), __builtin_bit_cast(float, hw.y << 16), __builtin_bit_cast(float, hw.y & 0xffff0000u)};
                    const f32x4 r1 = {__builtin_bit_cast(float, hw.z << 16), __builtin_bit_cast(float, hw.z & 0xffff0000u), __builtin_bit_cast(float, hw.w << 16), __builtin_bit_cast(float, hw.w & 0xffff0000u)};
                    const f32x4 h0 = r0 + acc[ai][bj][m][0], h1 = r1 + acc[ai][bj][m][1];
                    *(u32x4*)hp = pack8(h0, h1);
                    ss += dot4(h0) + dot4(h1); }
                ss += __shfl_xor(ss, 16); ss += __shfl_xor(ss, 32);
                if (fq == 0) SS[(size_t)row * 16 + u.pn * 4 + wc] = ss; }
    }
};
struct EpiPart {
    static constexpr bool PERM = true, AFTER_DRAIN = false;
    float* P; int M;
    __device__ __forceinline__ void operator()(const f32x4 (&acc)[2][2][4][2], const Unit& u, int wr, int wc, int fr, int fq, const PG8_LAS unsigned char* side) const {
        float* pb = P + (size_t)u.ks * M * 1024;
        const int row0 = u.pm * BM + wr * 64 + fr, col0 = u.pn * BM + wc * 32 + 8 * fq;
#pragma unroll
        for (int ai = 0; ai < 2; ++ai)
#pragma unroll
            for (int m = 0; m < 4; ++m) { const int row = row0 + ai * HALF + m * 16;
#pragma unroll
                for (int bj = 0; bj < 2; ++bj) { float* p = pb + (size_t)row * 1024 + col0 + bj * HALF; *(f32x4*)p = acc[ai][bj][m][0]; *(f32x4*)(p + 4) = acc[ai][bj][m][1]; } }
    }
};
template <class Epi, class Sched, bool ALIGN_EPI = false, bool SP2 = false>
__device__ __forceinline__ void gemm_phase(PG8_LAS unsigned char* lds, const Gemm g, const Sched& S, const Epi& E) {
    int tid_ = threadIdx.x; asm volatile("" : "+v"(tid_));
    const int tid = tid_, wid = __builtin_amdgcn_readfirstlane(tid >> 6), lane = tid & 63, wr = wid >> 2, wc = wid & 3, fr = lane & 15, fq = lane >> 4;
    const int K = g.K, nt = K / BK;
    unsigned voffA[2], voffB[2];
#pragma unroll
    for (int i = 0; i < 2; ++i) { int R, C; stage_rc(tid * 16 + i * 8192, R, C); const int Rb = Epi::PERM ? ((R & ~31) + perm32(R & 31)) : R;
        voffA[i] = (unsigned)(R * K + C) * 2u; voffB[i] = (unsigned)(Rb * K + C) * 2u; }
    const size_t kstep = (size_t)(BK * 2);
    const size_t hstep = (size_t)HALF * K * 2;
    const size_t tstep = 2 * hstep;
    const unsigned ldsw = (unsigned)wid * 1024u;
    const int aoff = lds_byte(wr * 64 + fr, fq * 8), boff = lds_byte(wc * 32 + fr, fq * 8);
#define PG8_SA(b, h) (((b) * 2 + (h)) * HTB)
#define PG8_SB(b, h) ((4 + (b) * 2 + (h)) * HTB)
#define PG8_STAGE(bufoff, gbase, voff) do { _Pragma("unroll") for (int _i = 0; _i < 2; ++_i) \
        __builtin_amdgcn_global_load_lds((const unsigned*)((const char*)(gbase) + (voff)[_i]), (PG8_LAS unsigned*)(lds + (bufoff) + ldsw + _i * 8192), 16, 0, 0); } while (0)
#define PG8_LDA(dst, b, h) do { _Pragma("unroll") for (int m = 0; m < 4; ++m) _Pragma("unroll") for (int k = 0; k < 2; ++k) dst[m][k] = *(const PG8_LAS bf16x8*)(lds + PG8_SA(b, h) + aoff + m * 2048 + k * 1024); } while (0)
#define PG8_LDB(dst, b, h) do { _Pragma("unroll") for (int n = 0; n < 2; ++n) _Pragma("unroll") for (int k = 0; k < 2; ++k) dst[n][k] = *(const PG8_LAS bf16x8*)(lds + PG8_SB(b, h) + boff + n * 2048 + k * 1024); } while (0)
#define PG8_MMA(ai, bj, At, Bt) do { __builtin_amdgcn_s_setprio(1); _Pragma("unroll") for (int m = 0; m < 4; ++m) _Pragma("unroll") for (int n = 0; n < 2; ++n) _Pragma("unroll") for (int k = 0; k < 2; ++k) \
        acc[ai][bj][m][n] = __builtin_amdgcn_mfma_f32_16x16x32_bf16(Bt[n][k], At[m][k], acc[ai][bj][m][n], 0, 0, 0); __builtin_amdgcn_s_setprio(0); } while (0)
#define PG8_WAIT_V(n) asm volatile("s_waitcnt vmcnt(" #n ")" ::: "memory")
#define PG8_WAIT_L(n) asm volatile("s_waitcnt lgkmcnt(" #n ")" ::: "memory")
#define PG8_BAR __builtin_amdgcn_s_barrier()
#define PG8_SCHED __builtin_amdgcn_sched_barrier(0)
    Unit cur, nxt; int ui = 0;
    if (!S.next(0, cur)) return;
    f32x4 acc[2][2][4][2];
#pragma unroll
    for (int a = 0; a < 2; ++a)
#pragma unroll
        for (int b = 0; b < 2; ++b)
#pragma unroll
            for (int m = 0; m < 4; ++m)
#pragma unroll
                for (int n = 0; n < 2; ++n) acc[a][b][m][n] = (f32x4){0.f, 0.f, 0.f, 0.f};
    bf16x8 At[4][2], B0[2][2], B1[2][2];
    const char* cA = (const char*)g.A + (size_t)cur.pm * tstep; const char* cB = (const char*)g.Bt + (size_t)cur.pn * tstep;
    if constexpr (Sched::SPLITK) { cA += (size_t)cur.k0 * kstep; cB += (size_t)cur.k0 * kstep; }
    S.a_ready(cur);
    if constexpr (SP2) {
        PG8_STAGE(PG8_SB(0, 0), cB, voffB); PG8_STAGE(PG8_SB(0, 1), cB + hstep, voffB); PG8_STAGE(PG8_SA(0, 0), cA, voffA); PG8_STAGE(PG8_SA(0, 1), cA + hstep, voffA);
        if (wr == 1) PG8_BAR;
        PG8_WAIT_V(2); PG8_BAR;
        PG8_STAGE(PG8_SB(1, 0), cB + kstep, voffB); PG8_STAGE(PG8_SA(1, 0), cA + kstep, voffA); PG8_STAGE(PG8_SB(1, 1), cB + hstep + kstep, voffB);
        PG8_WAIT_V(6); PG8_BAR;
    } else {
        PG8_STAGE(PG8_SB(0, 0), cB, voffB); PG8_STAGE(PG8_SA(0, 0), cA, voffA); PG8_STAGE(PG8_SB(0, 1), cB + hstep, voffB); PG8_STAGE(PG8_SA(0, 1), cA + hstep, voffA);
        if (wr == 1) PG8_BAR;
        PG8_WAIT_V(4); PG8_BAR;
        PG8_STAGE(PG8_SB(1, 0), cB + kstep, voffB); PG8_STAGE(PG8_SA(1, 0), cA + kstep, voffA); PG8_STAGE(PG8_SB(1, 1), cB + hstep + kstep, voffB);
        PG8_WAIT_V(6); PG8_BAR;
    }
    for (;;) {
        const bool has_next = S.next(ui + 1, nxt);
        const char* nA = has_next ? (const char*)g.A + (size_t)nxt.pm * tstep : cA; const char* nB = has_next ? (const char*)g.Bt + (size_t)nxt.pn * tstep : cB;
        if constexpr (Sched::SPLITK) { if (has_next) { nA += (size_t)nxt.k0 * kstep; nB += (size_t)nxt.k0 * kstep; } }
        const int ntc = Sched::SPLITK ? cur.nkt : nt;
        for (int t = 0; t < ntc; t += 2) {
            const bool last = (t == ntc - 2);
            const char* a1 = cA + (size_t)(t + 1) * kstep;
            const char* a2 = last ? nA : cA + (size_t)(t + 2) * kstep; const char* b2 = last ? nB : cB + (size_t)(t + 2) * kstep;
            const char* a3 = a2 + kstep; const char* b3 = b2 + kstep;
            if (last && has_next) S.a_ready(nxt);
            if constexpr (SP2) {
            PG8_LDB(B0, 0, 0); PG8_LDB(B1, 0, 1); PG8_SCHED; PG8_LDA(At, 0, 0); PG8_STAGE(PG8_SA(1, 1), a1 + hstep, voffA);
            PG8_WAIT_V(8); PG8_WAIT_L(0); PG8_BAR; PG8_MMA(0, 0, At, B0); PG8_MMA(0, 1, At, B1); PG8_BAR; PG8_SCHED;
            PG8_LDA(At, 0, 1); PG8_STAGE(PG8_SB(0, 0), b2, voffB); PG8_STAGE(PG8_SB(0, 1), b2 + hstep, voffB); PG8_STAGE(PG8_SA(0, 0), a2, voffA);
            PG8_WAIT_V(8); PG8_WAIT_L(0); PG8_BAR; PG8_MMA(1, 0, At, B0); PG8_MMA(1, 1, At, B1); PG8_BAR; PG8_SCHED;
            PG8_LDB(B0, 1, 0); PG8_LDB(B1, 1, 1); PG8_SCHED; PG8_LDA(At, 1, 0); PG8_STAGE(PG8_SA(0, 1), a2 + hstep, voffA);
            PG8_WAIT_V(8); PG8_WAIT_L(0); PG8_BAR; PG8_MMA(0, 0, At, B0); PG8_MMA(0, 1, At, B1); PG8_BAR; PG8_SCHED;
            PG8_LDA(At, 1, 1); PG8_STAGE(PG8_SB(1, 0), b3, voffB); PG8_STAGE(PG8_SB(1, 1), b3 + hstep, voffB); PG8_STAGE(PG8_SA(1, 0), a3, voffA);
            PG8_WAIT_V(8); PG8_WAIT_L(0); PG8_BAR; PG8_MMA(1, 0, At, B0); PG8_MMA(1, 1, At, B1); PG8_BAR; PG8_SCHED;
            } else {
            PG8_LDB(B0, 0, 0); PG8_SCHED; PG8_LDA(At, 0, 0); PG8_STAGE(PG8_SA(1, 1), a1 + hstep, voffA);
            PG8_WAIT_L(8); PG8_BAR; PG8_WAIT_L(0); PG8_MMA(0, 0, At, B0); PG8_BAR; PG8_SCHED;
            PG8_LDB(B1, 0, 1); PG8_STAGE(PG8_SB(0, 0), b2, voffB);
            PG8_BAR; PG8_WAIT_L(0); PG8_MMA(0, 1, At, B1); PG8_BAR;
            PG8_LDA(At, 0, 1); PG8_STAGE(PG8_SA(0, 0), a2, voffA);
            PG8_BAR; PG8_WAIT_L(0); PG8_MMA(1, 0, At, B0); PG8_BAR; PG8_SCHED;
            PG8_STAGE(PG8_SB(0, 1), b2 + hstep, voffB);
            PG8_WAIT_V(6); PG8_BAR; PG8_MMA(1, 1, At, B1); PG8_BAR;
            PG8_LDB(B0, 1, 0); PG8_SCHED; PG8_LDA(At, 1, 0); PG8_STAGE(PG8_SA(0, 1), a2 + hstep, voffA);
            PG8_WAIT_L(8); PG8_BAR; PG8_WAIT_L(0); PG8_MMA(0, 0, At, B0); PG8_BAR; PG8_SCHED;
            PG8_LDB(B1, 1, 1); PG8_STAGE(PG8_SB(1, 0), b3, voffB);
            PG8_BAR; PG8_WAIT_L(0); PG8_MMA(0, 1, At, B1); PG8_BAR;
            PG8_LDA(At, 1, 1); PG8_STAGE(PG8_SA(1, 0), a3, voffA);
            PG8_BAR; PG8_WAIT_L(0); PG8_MMA(1, 0, At, B0); PG8_BAR; PG8_SCHED;
            PG8_STAGE(PG8_SB(1, 1), b3 + hstep, voffB);
            PG8_WAIT_V(6); PG8_BAR; PG8_MMA(1, 1, At, B1); PG8_BAR;
            }
        }
        if constexpr (ALIGN_EPI) { if (wr == 0) PG8_BAR; }
        if constexpr (!Epi::AFTER_DRAIN) { E(acc, cur, wr, wc, fr, fq, lds + STAGE_BYTES); S.done(cur); }
        if (!has_next) break;
#pragma unroll
        for (int a = 0; a < 2; ++a)
#pragma unroll
            for (int b = 0; b < 2; ++b)
#pragma unroll
                for (int m = 0; m < 4; ++m)
#pragma unroll
                    for (int n = 0; n < 2; ++n) acc[a][b][m][n] = (f32x4){0.f, 0.f, 0.f, 0.f};
        cur = nxt; cA = nA; cB = nB; ++ui;
        if constexpr (ALIGN_EPI) { if (wr == 1) PG8_BAR; }
    }
    PG8_WAIT_V(0);
    if constexpr (!ALIGN_EPI) { if (wr == 0) PG8_BAR; }
    PG8_BAR;
    if constexpr (Epi::AFTER_DRAIN) { E.fused(acc, cur, wr, wc, fr, fq, lds, wid, lane); S.done(cur); }
#undef PG8_SA
#undef PG8_SB
#undef PG8_STAGE
#undef PG8_LDA
#undef PG8_LDB
#undef PG8_MMA
#undef PG8_WAIT_V
#undef PG8_WAIT_L
#undef PG8_BAR
#undef PG8_SCHED
}
}
#define GAS __attribute__((address_space(1)))
#define LAS __attribute__((address_space(3)))
typedef unsigned short bf16;
typedef unsigned v4u __attribute__((ext_vector_type(4)));
typedef float f32x4 __attribute__((ext_vector_type(4)));
typedef short bf16x8 __attribute__((ext_vector_type(8)));
typedef GAS unsigned gu32;
typedef GAS unsigned long long gu64;
#define RLX_AGENT __ATOMIC_RELAXED, __HIP_MEMORY_SCOPE_AGENT
#define LDS_WAIT() asm volatile("s_waitcnt lgkmcnt(0)" ::: "memory")
#define VM_WAIT() asm volatile("s_waitcnt vmcnt(0)" ::: "memory")
__device__ __forceinline__ unsigned long long rt() { return __builtin_amdgcn_s_memrealtime(); }
__device__ __forceinline__ unsigned f2bf(float f) { unsigned u = __builtin_bit_cast(unsigned, f); return (u + 0x7fffu + ((u >> 16) & 1u)) >> 16; }
__device__ __forceinline__ unsigned pk2(float lo, float hi) { return f2bf(lo) | (f2bf(hi) << 16); }

#define XB_TMO      128
#define XB_XCNT(j)  (256  + 64 * (j))
#define XB_XSUB(j)  (1280 + 64 * (j))
#define XB_XGEN(j)  (2304 + 64 * (j))
#define XB_TOP      3328
#define XB_TOPGEN   3392
#define XCD_BAR_WORDS 3456
#define XB_SPIN_CAP (1u << 18)

__device__ __forceinline__ unsigned xb_ld(unsigned* p)              { return __hip_atomic_load(p, __ATOMIC_RELAXED, __HIP_MEMORY_SCOPE_AGENT); }
__device__ __forceinline__ unsigned xb_add(unsigned* p, unsigned v) { return __hip_atomic_fetch_add(p, v, __ATOMIC_RELAXED, __HIP_MEMORY_SCOPE_AGENT); }
__device__ __forceinline__ unsigned xb_xcc_id() { return (unsigned)__builtin_amdgcn_s_getreg((3 << 11) | 20) & 0xFu; }
#define XB_SPIN(cond, bar) do { unsigned _sp = 0; while (cond) { __builtin_amdgcn_s_sleep(1); \
    if ((++_sp & 255u) == 0u) { if (xb_ld(&(bar)[XB_TMO])) break; if (_sp > XB_SPIN_CAP) { atomicAdd(&(bar)[XB_TMO], 1u); break; } } } } while (0)

struct XcdBarrier {
    unsigned* bar; unsigned x;
    volatile LAS unsigned* st;
};

__device__ __forceinline__ XcdBarrier xcd_barrier_post(unsigned* bar, volatile LAS unsigned* st) {
    XcdBarrier b; b.bar = bar; b.x = xb_xcc_id(); b.st = st;
    if (threadIdx.x == 0) (void)xb_add(&bar[XB_XCNT(b.x)], 1u);
    return b;
}
__device__ __forceinline__ void xcd_barrier_complete(unsigned* bar, unsigned x, unsigned& nloc, unsigned& nx) {
    const unsigned G = gridDim.x * gridDim.y * gridDim.z;
    unsigned sum, cnt, mine, sp = 0u;
    for (;;) {
        sum = 0u; cnt = 0u; mine = 0u;
#pragma unroll
        for (unsigned j = 0; j < 16; ++j) { const unsigned c = xb_ld(&bar[XB_XCNT(j)]); sum += c; cnt += (c > 0u) ? 1u : 0u; mine = (j == x) ? c : mine; }
        if (sum == G) break;
        __builtin_amdgcn_s_sleep(1);
        if ((++sp & 255u) == 0u) { if (xb_ld(&bar[XB_TMO])) break; if (sp > XB_SPIN_CAP) { atomicAdd(&bar[XB_TMO], 1u); break; } }
    }
    nloc = mine > 0u ? mine : 1u; nx = cnt > 0u ? cnt : 1u;
}

__device__ __forceinline__ void xcd_barrier(const XcdBarrier& b) {
    asm volatile("s_waitcnt vmcnt(0)" ::: "memory");
    __syncthreads();
    if (threadIdx.x == 0) {
        unsigned* bar = b.bar;
        __builtin_amdgcn_s_waitcnt(0);
        unsigned nloc = b.st[0], nx = b.st[1];
        if (nloc == 0u) { xcd_barrier_complete(bar, b.x, nloc, nx); b.st[0] = nloc; b.st[1] = nx; }
        const unsigned old = xb_add(&bar[XB_XSUB(b.x)], 1u);
        const unsigned gen = old / nloc;
        if (old + 1u == (gen + 1u) * nloc) {
            __builtin_amdgcn_fence(__ATOMIC_RELEASE, "agent");
            asm volatile("s_waitcnt vmcnt(0)" ::: "memory");
            const unsigned og = xb_add(&bar[XB_TOP], 1u);
            const unsigned tg = og / nx;
            if (og + 1u == (tg + 1u) * nx) xb_add(&bar[XB_TOPGEN], 1u);
            else XB_SPIN(xb_ld(&bar[XB_TOPGEN]) == tg, bar);
            __builtin_amdgcn_fence(__ATOMIC_ACQUIRE, "agent");
            xb_add(&bar[XB_XGEN(b.x)], 1u);
            asm volatile("s_waitcnt vmcnt(0)" ::: "memory");
        } else {
            XB_SPIN(xb_ld(&bar[XB_XGEN(b.x)]) == gen, bar);
            __builtin_amdgcn_fence(__ATOMIC_ACQUIRE, "agent");
            asm volatile("s_waitcnt vmcnt(0)" ::: "memory");
        }
    }
    __syncthreads();
}

constexpr int NWAVES = 8;
constexpr int D = 1024, NB = 32, SEQ = 2048, DB = 16, DSEQ = 64, NMETA = 16;
constexpr int HEADS = 4, DKH = 128, DVH = 256, RANK = 16, PW = 512, PG = 128, PBUF = 15, DFF = 2816;
constexpr int MP = NB * SEQ;
constexpr int MS = DB * DSEQ;
constexpr int MO = MP + MS;
constexpr int ROW_META = MO;
constexpr int MIN_ROWS = MO + 256;
constexpr int NPROJ = 4608;
constexpr int C_Q = 0, C_K = 512, C_V = 1024, C_P = 2048, C_GA = 2560, C_GB = 3584;
constexpr int NIN = 5632;
constexpr int NIN_ALLOC = 5888;
constexpr int NGU = 2 * DFF;
constexpr int D_IN = 5648;
constexpr size_t OFF_YP = 0, OFF_YS = (size_t)MP * D, OFF_SGP = OFF_YS + (size_t)MS * D, OFF_SPP = OFF_SGP + (size_t)NB * HEADS * DKH * DVH,
                 OFF_SGS = OFF_SPP + (size_t)NB * PBUF * PW, OFF_SPS = OFF_SGS + (size_t)DB * HEADS * DKH * DVH;
constexpr size_t MiB = 1u << 20;
constexpr size_t WS_CTL = 0, CTL_ZERO_BYTES = 1 * MiB;
constexpr size_t WS_WIN = 1 * MiB;
constexpr size_t WS_WOUT = 13 * MiB;
constexpr size_t WS_WGU = 15 * MiB;
constexpr size_t WS_WDN = 26 * MiB;
constexpr size_t WS_ALR = 32 * MiB;
constexpr size_t WS_WPT = 36 * MiB + 512 * 1024;
constexpr size_t WS_EXPBL = 37 * MiB;
constexpr size_t WS_SS2 = 40 * MiB;
constexpr size_t WS_SS3 = 44 * MiB + 512 * 1024;
constexpr size_t WS_XN = 50 * MiB;
constexpr size_t WS_MERGED = WS_XN;
constexpr size_t WS_PROJ = 182 * MiB;
constexpr size_t WS_ACT = WS_PROJ;
constexpr size_t WS_HB = WS_PROJ + 360 * MiB;
constexpr size_t WS_PH = WS_PROJ + (size_t)MIN_ROWS * NPROJ * 2;
constexpr size_t WS_HBS = WS_PH + 256 * 1024;
constexpr size_t WS_ACTS = WS_HBS + 2 * MiB;
constexpr size_t WS_PART = WS_ACTS + 6 * MiB;
constexpr size_t WS_END = WS_PART + 16 * MiB;
static_assert(WS_WIN + (size_t)NIN_ALLOC * D * 2 <= WS_WOUT && WS_WGU + (size_t)NGU * D * 2 <= WS_WDN && WS_WDN + (size_t)D * DFF * 2 <= WS_ALR, "ws map (weights)");
static_assert(WS_ALR + (size_t)MIN_ROWS * 64 <= WS_WPT && WS_WPT + 4 * 256 * 128 * 2 <= WS_EXPBL && WS_EXPBL + (size_t)4288 * 512 <= WS_SS2 && WS_SS2 + (size_t)MO * 64 <= WS_SS3 && WS_SS3 + (size_t)MO * 64 <= WS_XN, "ws map (small)");
static_assert(WS_XN + (size_t)MIN_ROWS * D * 2 <= WS_PROJ && WS_ACT + (size_t)MO * DFF * 2 <= WS_HB && WS_HB + (size_t)MO * D * 2 <= WS_PH, "ws map (big)");
constexpr int N_HELP = 128;
constexpr int CW_TMO = 0, CW_CODE = 1, CW_BAR = 4096, CW_HBAR = 8192, CW_LATE = 8192 + 64 * 8, CW_WTICKET = CW_LATE + 64;
constexpr int RING_OFF = 0, RING_BYTES = 131072;
constexpr int LDS_BYTES = 155648;
constexpr int LDSCTL_OFF = LDS_BYTES - 512, MISC_OFF = LDSCTL_OFF + 320;
constexpr int TAB_OFF = RING_OFF + RING_BYTES;
static_assert(TAB_OFF + 8 * 1024 + 64 <= LDSCTL_OFF, "epilogue tables");

struct Frame {
    LAS unsigned char* lds;
    volatile LAS unsigned* MISC;
    gu32* ctl;
    int tid, lane, wave, vcu, G;
};
__device__ __forceinline__ float wave_sum(float v) {
#pragma unroll
    for (int o = 1; o < 64; o <<= 1) v += __shfl_xor(v, o);
    return v;
}
__device__ __forceinline__ float bf2f(unsigned short u) { return __builtin_bit_cast(float, (unsigned)u << 16); }
__device__ __forceinline__ float bflo(unsigned u) { return __builtin_bit_cast(float, u << 16); }
__device__ __forceinline__ float bfhi(unsigned u) { return __builtin_bit_cast(float, u & 0xffff0000u); }

__device__ __forceinline__ void p0_transpose_item(const float* W, int ldw, int k0, int n0, int ncols, bf16* WT, int ldt, int dst_row0, const float* ksc, float sc, LAS float* scr, int lane, const bool vperm = false) {
#pragma unroll 8
    for (int i = 0; i < 32; ++i) { const int kk = 2 * i + (lane >> 5), n = lane & 31;
        float v = (n < ncols) ? W[(size_t)(k0 + kk) * ldw + n0 + n] : 0.f;
        v *= (ksc ? ksc[k0 + kk] : 1.0f) * sc;
        scr[kk * 33 + n] = v; }
    LDS_WAIT(); asm volatile("" ::: "memory");
    const int c = lane & 7;
#pragma unroll
    for (int j = 0; j < 4; ++j) { const int n = (lane >> 3) + 8 * j; const LAS float* s = scr + (8 * c) * 33 + n;
        v4u o; o.x = pk2(s[0 * 33], s[1 * 33]); o.y = pk2(s[2 * 33], s[3 * 33]); o.z = pk2(s[4 * 33], s[5 * 33]); o.w = pk2(s[6 * 33], s[7 * 33]);
        const int nd = vperm ? (((n >> 2) & 1) * 16 + (n >> 3) * 4 + (n & 3)) : n;
        if (n < ncols) *(GAS v4u*)(WT + (size_t)(dst_row0 + nd) * ldt + k0 + 8 * c) = o; }
    LDS_WAIT(); asm volatile("" ::: "memory");
}
__device__ __forceinline__ void rms_row_to_bf16(const float* xrow, const float* gain, bf16* orow, int lane) {
    const GAS f32x4* xr = (const GAS f32x4*)xrow + lane; const GAS f32x4* gr = (const GAS f32x4*)gain + lane;
    f32x4 v[4]; float s = 0.f;
#pragma unroll
    for (int j = 0; j < 4; ++j) { v[j] = xr[64 * j]; s += (v[j].x * v[j].x + v[j].y * v[j].y) + (v[j].z * v[j].z + v[j].w * v[j].w); }
    const float rstd = 1.0f / sqrtf(wave_sum(s) * (1.f / D) + 1e-6f);
    GAS unsigned long long* o8 = (GAS unsigned long long*)orow + lane;
#pragma unroll
    for (int j = 0; j < 4; ++j) { const f32x4 g = gr[64 * j];
        o8[64 * j] = (unsigned long long)pk2(v[j].x * rstd * g.x, v[j].y * rstd * g.y) | ((unsigned long long)pk2(v[j].z * rstd * g.z, v[j].w * rstd * g.w) << 32); }
}

struct Args { const float* in[18]; float* out; unsigned char* ws; };
typedef const __attribute__((address_space(4))) char* kargp_t;
__device__ __forceinline__ const void* karg(unsigned idx) {
    unsigned off = idx * 8u; asm volatile("" : "+s"(off));
    kargp_t kp = (kargp_t)__builtin_amdgcn_kernarg_segment_ptr();
    return *(const void* const __attribute__((address_space(4)))*)(kp + off);
}
#define KIN(i) ((const float*)karg(i))
#define KOUT() ((float*)karg(18))
#define KWS() ((unsigned char*)karg(19))


namespace wi {
constexpr int KB = D / 64;
constexpr int I_IN = KB * 176;
constexpr int I_WP = 4 * 2 * 8;
constexpr int I_OUT = KB * (D / 32);
constexpr int I_G = KB * (DFF / 32), I_U = I_G;
constexpr int I_DN = (DFF / 64) * (D / 32);
constexpr int N_EARLY = I_IN + I_WP;
constexpr int N_LATE = I_OUT + I_G + I_U + I_DN;
}
__device__ __forceinline__ void p0_weight_item(Frame& F, int r, LAS float* scr) {
    using namespace wi;
    unsigned char* ws = KWS();
    const float qsc = 0.08838834764831845f;
    if (r < I_IN) { const float* w_in = KIN(6); bf16* WIN = (bf16*)(ws + WS_WIN);
        const int kb = r / 176, nbk = r % 176; int src, dst, nc = 32; float sc = 1.0f;
        if (nbk < 64) { src = 32 * nbk; dst = 32 * nbk; if (nbk < 16) sc = qsc; }
        else if (nbk < 80) { const int i = nbk - 64; src = 3088 + 32 * i; dst = 2048 + 32 * i; }
        else if (nbk < 144) { const int i = nbk - 80, j = i >> 3, hf = (i >> 2) & 1, sub = i & 3; src = (hf ? 3600 : 2048) + 128 * j + 32 * sub; dst = 2560 + 256 * j + 128 * hf + 32 * sub; }
        else { const int i = nbk - 144; src = 4624 + 32 * i; dst = 4608 + 32 * i; }
        p0_transpose_item(w_in, D_IN, 64 * kb, src, nc, WIN, D, dst, nullptr, sc, scr, F.lane, nbk >= 32 && nbk < 64); return; } r -= I_IN;
    if (r < I_WP) { const float* w_pool = KIN(10); const int gi = r >> 4, kb = (r >> 3) & 1, nb = r & 7;
        p0_transpose_item(w_pool + (size_t)gi * PG * DVH, DVH, 64 * kb, 32 * nb, 32, (bf16*)(ws + WS_WPT), PG, gi * DVH + 32 * nb, nullptr, 1.0f, scr, F.lane); return; } r -= I_WP;
    if (r < I_OUT) { const int kb = r / 32, nb = r % 32; p0_transpose_item(KIN(12), D, 64 * kb, 32 * nb, 32, (bf16*)(ws + WS_WOUT), D, 32 * nb, nullptr, 1.0f, scr, F.lane); return; } r -= I_OUT;
    if (r < I_G) { const int kb = r / 88, nb = r % 88; p0_transpose_item(KIN(14), DFF, 64 * kb, 32 * nb, 32, (bf16*)(ws + WS_WGU), D, (nb >> 2) * 256 + (nb & 3) * 32, KIN(13), 1.0f, scr, F.lane); return; } r -= I_G;
    if (r < I_U) { const int kb = r / 88, nb = r % 88; p0_transpose_item(KIN(15), DFF, 64 * kb, 32 * nb, 32, (bf16*)(ws + WS_WGU), D, (nb >> 2) * 256 + 128 + (nb & 3) * 32, KIN(13), 1.0f, scr, F.lane); return; } r -= I_U;
    { const int kb = r / 32, nb = r % 32; p0_transpose_item(KIN(16), D, 64 * kb, 32 * nb, 32, (bf16*)(ws + WS_WDN), DFF, 32 * nb, nullptr, 1.0f, scr, F.lane); }
}
__device__ __forceinline__ void late_weight_items(Frame& F, const int e, const int ne) {
    LAS float* scr = (LAS float*)(F.lds + RING_OFF + F.wave * 16384);
    for (int t = e * NWAVES + F.wave; t < wi::N_LATE; t += ne * NWAVES) p0_weight_item(F, wi::N_EARLY + t, scr);
}
__device__ __forceinline__ void p0_prologue(Frame& F) {
    unsigned char* ws = KWS();
    LAS float* scr = (LAS float*)(F.lds + RING_OFF + F.wave * 16384);
    const int gw = F.vcu * NWAVES + F.wave, NGW = F.G * NWAVES;
    bf16* WIN = (bf16*)(ws + WS_WIN);
    for (int it = gw; it < wi::N_EARLY; it += NGW) p0_weight_item(F, it, scr);
    { GAS v4u* z = (GAS v4u*)(WIN + (size_t)(5632 + 16) * D); const int n16 = 240 * 2048 / 16; const v4u zero = {0u, 0u, 0u, 0u};
      for (int i = gw * 64 + F.lane; i < n16; i += NGW * 64) z[i] = zero; }
    { const float* sp = KIN(3); bf16* PH = (bf16*)(ws + WS_PH); for (int i = gw * 64 + F.lane; i < DB * PBUF * PW; i += NGW * 64) PH[i] = (bf16)f2bf(sp[i]); }
    bf16* XN = (bf16*)(ws + WS_XN); const float* g1 = KIN(5); const float* xpr = KIN(0); const float* xsm = KIN(1); const float* xmt = KIN(4);
    float* ALRO = (float*)(ws + WS_ALR);
    constexpr int LP = 2064;
    LAS unsigned char* Wt = F.lds + RING_OFF;
    LAS unsigned char* At = F.lds + RING_OFF + 16 * LP + 256 + F.wave * (4 * LP + 192);
    __syncthreads();
    { const float* w_in = KIN(6); const int k0 = 2 * F.tid; const float* w0 = w_in + (size_t)k0 * D_IN + 3072;
#pragma unroll
      for (int q = 0; q < 4; ++q) { const f32x4 a = *(const f32x4*)(w0 + 4 * q), b = *(const f32x4*)(w0 + D_IN + 4 * q);
#pragma unroll
          for (int i = 0; i < 4; ++i) *(LAS unsigned*)(Wt + (4 * q + i) * LP + 2 * k0) = pk2(a[i], b[i]); } }
    __syncthreads();
    int lz = F.lane; asm volatile("" : "+v"(lz));
    const unsigned l15 = lz & 15, kq = lz >> 4;
    const LAS unsigned char* wrd = Wt + l15 * LP + 16 * kq;
    const LAS unsigned char* ard = At + (l15 & 3) * LP + 16 * kq;
    LAS unsigned char* awr = At + 8 * lz;
    const GAS f32x4* gr = (const GAS f32x4*)g1 + F.lane;
    f32x4 gv[4];
#pragma unroll
    for (int j = 0; j < 4; ++j) gv[j] = gr[64 * j];
#define P0_ROWPTR(m) (((m) < MP) ? xpr + (size_t)(m) * D : ((m) < MO) ? xsm + (size_t)((m) - MP) * D : xmt + (size_t)(((m) < MO + NMETA ? (m) : MO) - MO) * D)
    f32x4 vn[4][4];
    { const int m0 = 4 * gw;
      if (m0 < MIN_ROWS) {
#pragma unroll
        for (int r = 0; r < 4; ++r) { const GAS f32x4* xr = (const GAS f32x4*)P0_ROWPTR(m0 + r) + F.lane;
#pragma unroll
            for (int j = 0; j < 4; ++j) vn[r][j] = __builtin_nontemporal_load(&xr[64 * j]); } } }
    for (int m0 = 4 * gw; m0 < MIN_ROWS; m0 += 4 * NGW) {
        f32x4 v[4][4];
#pragma unroll
        for (int r = 0; r < 4; ++r)
#pragma unroll
            for (int j = 0; j < 4; ++j) v[r][j] = vn[r][j];
        { const int mn = (m0 + 4 * NGW < MIN_ROWS) ? m0 + 4 * NGW : m0;
#pragma unroll
          for (int r = 0; r < 4; ++r) { const GAS f32x4* xr = (const GAS f32x4*)P0_ROWPTR(mn + r) + F.lane;
#pragma unroll
              for (int j = 0; j < 4; ++j) vn[r][j] = __builtin_nontemporal_load(&xr[64 * j]); } }
#pragma unroll
        for (int r = 0; r < 4; ++r) { const int m = m0 + r; float s = 0.f;
#pragma unroll
            for (int j = 0; j < 4; ++j) s += (v[r][j].x * v[r][j].x + v[r][j].y * v[r][j].y) + (v[r][j].z * v[r][j].z + v[r][j].w * v[r][j].w);
            const float rstd = (m < MO + NMETA) ? 1.0f / sqrtf(wave_sum(s) * (1.f / D) + 1e-6f) : 0.f;
            GAS unsigned long long* o8 = (GAS unsigned long long*)(XN + (size_t)m * D) + F.lane;
#pragma unroll
            for (int j = 0; j < 4; ++j) { const f32x4 g = gv[j];
                const unsigned long long w_ = (unsigned long long)pk2(v[r][j].x * rstd * g.x, v[r][j].y * rstd * g.y) | ((unsigned long long)pk2(v[r][j].z * rstd * g.z, v[r][j].w * rstd * g.w) << 32);
                o8[64 * j] = w_; *(LAS unsigned long long*)(awr + r * LP + 512 * j) = w_; } }
        asm volatile("s_waitcnt lgkmcnt(0)" ::: "memory");
        f32x4 acc0 = {0.f, 0.f, 0.f, 0.f}, acc1 = acc0;
#pragma unroll
        for (int ks = 0; ks < 32; ks += 2) {
            acc0 = __builtin_amdgcn_mfma_f32_16x16x32_bf16(*(const LAS bf16x8*)(ard + 64 * ks), *(const LAS bf16x8*)(wrd + 64 * ks), acc0, 0, 0, 0);
            acc1 = __builtin_amdgcn_mfma_f32_16x16x32_bf16(*(const LAS bf16x8*)(ard + 64 * ks + 64), *(const LAS bf16x8*)(wrd + 64 * ks + 64), acc1, 0, 0, 0); }
        const f32x4 acc = acc0 + acc1;
        if (kq == 0) {
#pragma unroll
            for (int e = 0; e < 4; ++e) ALRO[(size_t)(m0 + e) * 16 + l15] = acc[e]; }
        asm volatile("s_waitcnt lgkmcnt(0)" ::: "memory");
    }
#undef P0_ROWPTR
    __syncthreads();
}


typedef short s16x4 __attribute__((ext_vector_type(4)));
typedef unsigned u32x2 __attribute__((ext_vector_type(2)));
typedef float f32x2g __attribute__((ext_vector_type(2)));
typedef __bf16 bf16x2n __attribute__((ext_vector_type(2)));
__device__ __forceinline__ unsigned pkbf(float a, float b) { f32x2g v = {a, b}; bf16x2n r = __builtin_convertvector(v, bf16x2n); return __builtin_bit_cast(unsigned, r); }
__device__ __forceinline__ unsigned off_b(unsigned row, unsigned ch) { return 256u * row + 16u * (ch ^ (((row & 3u) << 2) | ((row >> 2) & 3u))); }
#define MFMA16(a, b, c) __builtin_amdgcn_mfma_f32_16x16x32_bf16((a), (b), (c), 0, 0, 0)
__device__ __forceinline__ bf16x8 tr_frag(LAS unsigned char* img, unsigned lane, unsigned c, unsigned ks) {
    const unsigned g = lane >> 4, q = (lane & 15) >> 2, p = lane & 3;
    const unsigned a0 = off_b(32 * ks + 8 * g + q, 2 * c + (p >> 1)) + 8 * (p & 1), a1 = off_b(32 * ks + 8 * g + 4 + q, 2 * c + (p >> 1)) + 8 * (p & 1);
    const s16x4 lo = __builtin_amdgcn_ds_read_tr16_b64_v4i16((LAS s16x4*)(img + a0)), hi = __builtin_amdgcn_ds_read_tr16_b64_v4i16((LAS s16x4*)(img + a1));
    return __builtin_shufflevector(lo, hi, 0, 1, 2, 3, 4, 5, 6, 7);
}
__device__ __forceinline__ bf16x8 row_frag(LAS unsigned char* img, unsigned lane, unsigned rb, unsigned ks) { return *(const LAS bf16x8*)(img + off_b((lane & 15) + 16 * rb, 4 * ks + (lane >> 4))); }

constexpr int N_ITEMS_P = NB * HEADS * 33, N_ITEMS = N_ITEMS_P + DB * HEADS;
#define GLA_CBASE(prm, b, cc) ((prm) ? ((cc) == 0 ? ROW_META - 48 : (b) * SEQ + ((cc) - 1) * 64) : (MP + (b) * DSEQ))

constexpr int QK_STAGE = 32768;
constexpr int QK_ALR = 0;
typedef float f32x2q __attribute__((ext_vector_type(2)));
__device__ __forceinline__ f32x2q logsig16_pk(f32x2q x) {
    f32x2q r;
#pragma unroll
    for (int e = 0; e < 2; ++e) { const float xc = __builtin_amdgcn_fmed3f(x[e], -80.0f, 80.0f); r[e] = __builtin_amdgcn_logf(1.0f + __builtin_amdgcn_exp2f(xc * -1.44269504089f)) * (-0.69314718056f / 16.0f); }
    return r;
}
template <int TMIN>
__device__ __forceinline__ void gla_qk_item(bf16* PROJ, const float* ALRF, float* EXPBL, const float* w2, const float* b_alpha, LAS unsigned char* La, LAS unsigned char* Ls, const unsigned lane, const int item, const int cbase, const int h) {
    { const float* ap = ALRF + (size_t)cbase * 16;
#pragma unroll
      for (int q = 0; q < 4; ++q) { const unsigned i = lane + 64u * q; const f32x4 v = ((int)(i >> 2) >= TMIN) ? *(const f32x4*)(ap + 4u * i) : (f32x4){0.f, 0.f, 0.f, 0.f}; *(LAS f32x4*)(La + 16u * i) = v; } }
    f32x2q w2r[16];
#pragma unroll
    for (int j = 0; j < 16; ++j) w2r[j] = *(const f32x2q*)(w2 + j * 512 + h * DKH + 2 * lane);
    const f32x2q bias = *(const f32x2q*)(b_alpha + h * DKH + 2 * lane);
    asm volatile("s_waitcnt lgkmcnt(0)" ::: "memory");
    f32x2q bsum = {0.f, 0.f};
    LAS unsigned char* Lq = Ls, *Lk = Ls + 4096;
    const unsigned srow = lane >> 4, sch = lane & 15u;
    const bf16* qg = PROJ + (size_t)cbase * NPROJ + C_Q + h * DKH + 8u * sch; const bf16* kg = PROJ + (size_t)cbase * NPROJ + C_K + h * DKH + 8u * sch;
    v4u nq[4], nk[4];
#define QK_FETCH(qr) do { _Pragma("unroll") for (int i = 0; i < 4; ++i) { const unsigned t = 16u * (qr) + 4u * i + srow; nq[i] = *(const v4u*)(qg + t * NPROJ); nk[i] = *(const v4u*)(kg + t * NPROJ); } } while (0)
    constexpr int Q0 = TMIN / 16;
    QK_FETCH(Q0);
#pragma unroll 1
    for (int qr = Q0; qr < 4; ++qr) {
#pragma unroll
        for (int i = 0; i < 4; ++i) { *(LAS v4u*)(Lq + (4u * i + srow) * 256u + 16u * sch) = nq[i]; *(LAS v4u*)(Lk + (4u * i + srow) * 256u + 16u * sch) = nk[i]; }
        asm volatile("s_waitcnt lgkmcnt(0)" ::: "memory");
        { const int qn = (qr + 1 < 4) ? qr + 1 : qr; QK_FETCH(qn); }
#pragma unroll
        for (int r = 0; r < 16; ++r) { const int t = 16 * qr + r;
            const LAS f32x4* ar = (const LAS f32x4*)(La + t * 64); const f32x4 a0 = ar[0], a1 = ar[1], a2 = ar[2], a3 = ar[3];
            f32x2q x0 = bias, x1 = {0.f, 0.f};
#pragma unroll
            for (int j = 0; j < 4; ++j) { x0 += w2r[j] * a0[j]; x1 += w2r[4 + j] * a1[j]; x0 += w2r[8 + j] * a2[j]; x1 += w2r[12 + j] * a3[j]; }
            bsum += logsig16_pk(x0 + x1);
            const float e0 = pg8::fast_exp(bsum[0]), e1 = pg8::fast_exp(bsum[1]), n0 = pg8::fast_exp(-bsum[0]), n1 = pg8::fast_exp(-bsum[1]);
            LAS unsigned* qw = (LAS unsigned*)(Lq + r * 256 + 4u * lane); LAS unsigned* kw = (LAS unsigned*)(Lk + r * 256 + 4u * lane);
            const unsigned sq = *qw, sk = *kw;
            *qw = pkbf(bflo(sq) * e0, bfhi(sq) * e1); *kw = pkbf(bflo(sk) * n0, bfhi(sk) * n1); }
        asm volatile("s_waitcnt lgkmcnt(0)" ::: "memory");
#pragma unroll
        for (int i = 0; i < 4; ++i) { const unsigned t = 16u * qr + 4u * i + srow;
            *(v4u*)(const_cast<bf16*>(qg) + t * NPROJ) = *(const LAS v4u*)(Lq + (4u * i + srow) * 256u + 16u * sch); *(v4u*)(const_cast<bf16*>(kg) + t * NPROJ) = *(const LAS v4u*)(Lk + (4u * i + srow) * 256u + 16u * sch); }
        asm volatile("s_waitcnt lgkmcnt(0)" ::: "memory");
    }
#undef QK_FETCH
    *(f32x2q*)(EXPBL + (size_t)item * 128 + 2 * lane) = (f32x2q){pg8::fast_exp(bsum[0]), pg8::fast_exp(bsum[1])};
    asm volatile("s_waitcnt lgkmcnt(0)" ::: "memory");
}
__device__ __forceinline__ void gla_prep_qk(Frame& F, const int c_lo, const int c_hi, const bool with_sample, const int gw, const int NGW) {
    unsigned char* ws = KWS();
    bf16* PROJ = (bf16*)(ws + WS_PROJ); const float* ALRF = (const float*)(ws + WS_ALR); float* EXPBL = (float*)(ws + WS_EXPBL);
    const float* w2 = KIN(7); const float* b_alpha = KIN(8);
    int tid_ = F.tid; asm volatile("" : "+v"(tid_));
    const unsigned lane = (unsigned)tid_ & 63u;
    LAS unsigned char* La = F.lds + QK_ALR + F.wave * 4096;
    LAS unsigned char* Ls = F.lds + QK_STAGE + F.wave * 8192;
    const int nc = c_hi - c_lo, n_prompt = NB * HEADS * nc, total = n_prompt + (with_sample ? DB * HEADS : 0);
    for (int idx = gw; idx < total; idx += NGW) {
        const bool prm = idx < n_prompt;
        int b, h, c, item;
        if (prm) { const int bh = idx / nc; c = c_lo + (idx - bh * nc); b = bh >> 2; h = bh & 3; item = bh * 33 + c; } else { const int i = idx - n_prompt; b = i >> 2; h = i & 3; c = 0; item = N_ITEMS_P + i; }
        if (prm && c == 0 && b != 0) continue;
        const int cbase = GLA_CBASE(prm, b, c);
        if (prm && c == 0) gla_qk_item<48>(PROJ, ALRF, EXPBL, w2, b_alpha, La, Ls, lane, item, cbase, h);
        else gla_qk_item<0>(PROJ, ALRF, EXPBL, w2, b_alpha, La, Ls, lane, item, cbase, h);
    }
}

constexpr int PL_WP = 0;
constexpr int PL_MIX = 65536;
__device__ __forceinline__ void unpack8(const v4u w, f32x4& lo, f32x4& hi) { lo = (f32x4){bflo(w[0]), bfhi(w[0]), bflo(w[1]), bfhi(w[1])}; hi = (f32x4){bflo(w[2]), bfhi(w[2]), bflo(w[3]), bfhi(w[3])}; }
template <int WIN>
__device__ __forceinline__ void gla_pool_units(Frame& F, bf16* PROJ, float* outp, LAS unsigned char* L, const unsigned lane, const int h, const int t_lo, const int t_hi, const bool with_sample, const int hw, const int NHW) {
    constexpr float rwin = 1.0f / (float)WIN;
    constexpr unsigned PHOFF = (unsigned)MIN_ROWS * NPROJ;
    LAS unsigned char* Lm = L + PL_MIX + F.wave * 4096;
    const int nt = t_hi - t_lo, n_prompt = NB * nt, total = n_prompt + (with_sample ? DB * 4 : 0);
    for (int u = hw; u < total; u += NHW) {
        unsigned lz = lane; asm volatile("" : "+v"(lz));
        const bool prm = u < n_prompt; int b, tile;
        if (prm) { b = u / nt; tile = t_lo + (u - b * nt); } else { const int su = u - n_prompt; b = su >> 2; tile = su & 3; }
        const int t0 = 16 * tile;
        const unsigned row0 = prm ? b * SEQ : MP + b * DSEQ;
        const bool last = prm ? tile == 127 : tile == 3;
        {
            const int o = lz & 15, rq = lz >> 4; const int tb = t0 + 4 * rq;
            const unsigned curoff = row0 * NPROJ + C_P + h * PG + 8 * o;
            const unsigned negoff = prm ? (unsigned)(ROW_META + 16) * NPROJ + C_P + h * PG + 8 * o : PHOFF + (unsigned)(b * PBUF + PBUF) * PW + h * PG + 8 * o;
            const unsigned dneg = negoff - curoff; const int dpitch = prm ? 0 : PW - NPROJ;
#define POOL_ROW(tq) (*(const v4u*)(PROJ + (curoff + (unsigned)((tq) * NPROJ) + ((unsigned)((tq) >> 31) & (dneg + (unsigned)((tq) * dpitch))))))
            f32x4 s0 = {0.f, 0.f, 0.f, 0.f}, s1 = s0, c0[4], c1[4];
            v4u wn[4], wo[3];
#pragma unroll
            for (int i = 0; i < 4; ++i) wn[i] = POOL_ROW(tb + i);
#pragma unroll
            for (int i = 0; i < 3; ++i) wo[i] = POOL_ROW(tb + 1 + i - WIN);
#pragma unroll
            for (int j0 = 1; j0 < WIN; j0 += 8) { v4u pw[8];
#pragma unroll
                for (int jj = 0; jj < 8; ++jj) if (j0 + jj < WIN) pw[jj] = POOL_ROW(tb - (j0 + jj));
#pragma unroll
                for (int jj = 0; jj < 8; ++jj) if (j0 + jj < WIN) { f32x4 lo, hi; unpack8(pw[jj], lo, hi); s0 += lo; s1 += hi; } }
#pragma unroll
            for (int i = 0; i < 4; ++i) { unpack8(wn[i], c0[i], c1[i]); s0 += c0[i]; s1 += c1[i];
                if (i > 0) { f32x4 lo, hi; unpack8(wo[i - 1], lo, hi); s0 -= lo; s1 -= hi; }
                const f32x4 m0 = s0 * rwin - c0[i], m1 = s1 * rwin - c1[i];
                *(LAS v4u*)(Lm + off_b(4 * rq + i, o)) = (v4u){pkbf(m0[0], m0[1]), pkbf(m0[2], m0[3]), pkbf(m1[0], m1[1]), pkbf(m1[2], m1[3])};
                if (last && (4 * rq + i) >= 1) { float* po = outp + (prm ? OFF_SPP : OFF_SPS) + (size_t)(b * PBUF + (4 * rq + i - 1)) * PW + h * PG + 8 * o; *(f32x4*)po = c0[i]; *(f32x4*)(po + 4) = c1[i]; } }
#undef POOL_ROW
        }
        asm volatile("s_waitcnt lgkmcnt(0)" ::: "memory");
        const int l15 = lz & 15, g = lz >> 4;
        unsigned aks[4];
#pragma unroll
        for (int ks = 0; ks < 4; ++ks) aks[ks] = 256u * l15 + 16u * (g ^ ((l15 >> 2) & 3)) + 64u * (ks ^ (l15 & 3));
        bf16x8 mixf[4];
#pragma unroll
        for (int ks = 0; ks < 4; ++ks) mixf[ks] = *(const LAS bf16x8*)(Lm + aks[ks]);
        const unsigned gboff = (row0 + (unsigned)(t0 + l15)) * NPROJ + C_GB + h * DVH + 8 * g;
#pragma unroll
        for (int half = 0; half < 2; ++half) {
            v4u gbw[4];
#pragma unroll
            for (int dp = 0; dp < 4; ++dp) gbw[dp] = *(const v4u*)(PROJ + (gboff + 32u * (4 * half + dp)));
            f32x4 y[8];
#pragma unroll
            for (int d = 0; d < 8; ++d) { y[d] = (f32x4){0.f, 0.f, 0.f, 0.f};
#pragma unroll
                for (int ks = 0; ks < 4; ++ks) y[d] = MFMA16(*(const LAS bf16x8*)(L + PL_WP + aks[ks] + 4096 * (8 * half + d)), mixf[ks], y[d]); }
#pragma unroll
            for (int dp = 0; dp < 4; ++dp) { v4u ow;
#pragma unroll
                for (int hh = 0; hh < 2; ++hh) { const f32x4 yy = y[2 * dp + hh]; const unsigned w0 = gbw[dp][2 * hh], w1 = gbw[dp][2 * hh + 1];
                    ow[2 * hh] = pkbf(bflo(w0) * yy[0], bfhi(w0) * yy[1]); ow[2 * hh + 1] = pkbf(bflo(w1) * yy[2], bfhi(w1) * yy[3]); }
                *(v4u*)(PROJ + (gboff + 32u * (4 * half + dp))) = ow; }
            asm volatile("" ::: "memory");
        }
        asm volatile("s_waitcnt lgkmcnt(0)" ::: "memory");
    }
}
__device__ __forceinline__ void gla_prep_pool(Frame& F, const int t_lo, const int t_hi, const bool with_sample, const int hw, const int NHW) {
    unsigned char* ws = KWS(); float* outp = KOUT();
    bf16* PROJ = (bf16*)(ws + WS_PROJ); const bf16* WPT = (const bf16*)(ws + WS_WPT);
    LAS unsigned char* L = F.lds;
    int tid_ = F.tid; asm volatile("" : "+v"(tid_));
    const int tid = tid_; const unsigned lane = (unsigned)tid & 63u;
    const int h = F.vcu & 3;
    __syncthreads();
    { const bf16* wph = WPT + (size_t)h * DVH * PG;
#pragma unroll
      for (int q = 0; q < 8; ++q) { const unsigned i = (unsigned)tid + 512u * q, row = i >> 4, ch = i & 15u;
          const unsigned srow = 32u * (row >> 5) + 8u * ((row >> 2) & 3u) + 4u * ((row >> 4) & 1u) + (row & 3u);
          *(LAS v4u*)(L + PL_WP + off_b(row, ch)) = *(const v4u*)(wph + srow * PG + 8u * ch); } }
    __syncthreads();
    if (h == 0) gla_pool_units<2>(F, PROJ, outp, L, lane, h, t_lo, t_hi, with_sample, hw, NHW);
    else if (h == 1) gla_pool_units<4>(F, PROJ, outp, L, lane, h, t_lo, t_hi, with_sample, hw, NHW);
    else if (h == 2) gla_pool_units<8>(F, PROJ, outp, L, lane, h, t_lo, t_hi, with_sample, hw, NHW);
    else gla_pool_units<16>(F, PROJ, outp, L, lane, h, t_lo, t_hi, with_sample, hw, NHW);
    __syncthreads();
}

__device__ __forceinline__ void dma16(const void* gsrc, unsigned lds_dst) {
    unsigned keep;
    asm volatile("s_mov_b32 %0, m0\n\ts_mov_b32 m0, %2\n\ts_nop 0\n\tglobal_load_lds_dwordx4 %1, off\n\ts_mov_b32 m0, %0" : "=&s"(keep) : "v"(gsrc), "s"(lds_dst) : "memory");
}
constexpr int SC_BUF = 66560, SC_QT = 0, SC_KT = 16384, SC_V = 32768, SC_EX = 65536, SC_AT = 2 * SC_BUF, SC_RS = SC_AT + 9216, SC_END = SC_RS + 2 * 2048;
constexpr int AT_PITCH = 144;
static_assert(SC_END <= LDSCTL_OFF, "scan LDS map");
__device__ __forceinline__ void gla_scan(Frame& F, const int K0) {
    unsigned char* ws = KWS(); const float* st_gla = KIN(2); float* outp = KOUT();
    const bf16* ZPAGE = (const bf16*)(ws + WS_WIN) + (size_t)(5632 + 16) * D;
    const bf16* PROJ = (const bf16*)(ws + WS_PROJ); const float* EXPBL = (const float*)(ws + WS_EXPBL); bf16* MERGED = (bf16*)(ws + WS_MERGED);
    LAS unsigned char* L = F.lds; const unsigned lbase = (unsigned)(size_t)L;
    int tid_ = F.tid; asm volatile("" : "+v"(tid_));
    const int tid = tid_; const int w = F.wave;
    for (int u = F.vcu; u < 192; u += F.G) {
        const bool prm = u < 128; const int b = prm ? (u >> 2) : ((u - 128) >> 2), h = u & 3;
        int tu = tid; asm volatile("" : "+v"(tu));
        f32x4 S[8][2];
        { const unsigned l15u = tu & 15, gu = (tu >> 4) & 3; const float* s0h = st_gla + (size_t)(b * HEADS + h) * DKH * DVH + 32 * w;
#pragma unroll
          for (int kt = 0; kt < 8; ++kt)
#pragma unroll
            for (int dt = 0; dt < 2; ++dt) {
                if (prm) S[kt][dt] = (f32x4){0.f, 0.f, 0.f, 0.f};
                else { const unsigned o0 = (16u * kt + 4u * gu) * DVH + 8u * (l15u >> 2) + 4u * dt + (l15u & 3u); S[kt][dt] = (f32x4){s0h[o0], s0h[o0 + DVH], s0h[o0 + 2 * DVH], s0h[o0 + 3 * DVH]}; }
            } }
#define SCAN_ISSUE(cc, tm, tz, bf) do { const int cb_ = GLA_CBASE(prm, b, cc); const bf16* crow_ = PROJ + (size_t)cb_ * NPROJ + h * DVH; const bf16* crowk_ = PROJ + (size_t)cb_ * NPROJ + h * DKH; \
            const unsigned l_ = (unsigned)(tz) & 63u; const unsigned Lb_ = lbase + (unsigned)((bf) * SC_BUF); \
            _Pragma("unroll") for (int q = 0; q < 2; ++q) { const unsigned s = 4u * (q * 8u + w) + (l_ >> 4), ch = (l_ & 15u) ^ (((s & 3u) << 2) | ((s >> 2) & 3u)); const bool ok = (int)s >= (tm); \
                const bf16* srcq = ok ? crowk_ + (s * NPROJ + C_Q + 8u * ch) : ZPAGE + 8u * l_; const bf16* srck = ok ? crowk_ + (s * NPROJ + C_K + 8u * ch) : ZPAGE + 8u * l_; \
                dma16(srcq, Lb_ + SC_QT + (q * 8 + w) * 1024); dma16(srck, Lb_ + SC_KT + (q * 8 + w) * 1024); \
                _Pragma("unroll") for (int hf = 0; hf < 2; ++hf) { const bf16* srcv = ok ? crow_ + (s * NPROJ + C_V + hf * 128u + 8u * ch) : ZPAGE + 8u * l_; \
                    dma16(srcv, Lb_ + SC_V + hf * 16384 + (q * 8 + w) * 1024); } } \
            if (w == 0) { const int it_ = prm ? (((cc) == 0 ? 0 : b) * HEADS + h) * 33 + (cc) : N_ITEMS_P + b * HEADS + h; \
                dma16(EXPBL + (size_t)it_ * 128 + 4u * (l_ & 31u), Lb_ + SC_EX); } } while (0)
#pragma unroll
        for (int kt = 0; kt < 8; ++kt) asm volatile("" : "+v"(S[kt][0]), "+v"(S[kt][1]));
        __syncthreads();
        SCAN_ISSUE(0, (prm ? 48 : 0), tu, 0);
        asm volatile("s_waitcnt vmcnt(0)" ::: "memory");
        __syncthreads();
        const int nchunk = prm ? 33 : 1;
        for (int c2 = 0; c2 < nchunk; c2 += 2) {
#pragma unroll
          for (int par = 0; par < 2; ++par) {
            const int c = c2 + par; if (c >= nchunk) break;
            const int cbase = GLA_CBASE(prm, b, c);
            const bool emit = !(prm && c == 0);
            int tc = tid; asm volatile("" : "+v"(tc));
            const unsigned lane = (unsigned)tc & 63u; const int l15 = lane & 15, g = lane >> 4;
            const unsigned c2_ = ((unsigned)l15 >> 2) & 3u, l3_ = (unsigned)l15 & 3u, gh_ = (unsigned)g >> 1, g8_ = 8u * ((unsigned)g & 1u);
            const unsigned RB = 256u * l15 + 16u * ((unsigned)g ^ c2_);
            const unsigned Q0 = 256u * l15 + 16u * (gh_ ^ c2_) + g8_, Q1 = 256u * l15 + 16u * ((gh_ | 2u) ^ c2_) + g8_;
            unsigned xk[4];
#pragma unroll
            for (int ks = 0; ks < 4; ++ks) xk[ks] = 64u * ((unsigned)ks ^ l3_);
            const unsigned tq_ = (unsigned)l15 >> 2, tp_ = l3_;
            const unsigned s0_ = (tq_ << 2) | ((2u * g) & 3u), s1_ = (tq_ << 2) | ((2u * g + 1u) & 3u);
            const unsigned u0 = s0_ >> 1, u1 = s1_ >> 1;
            const unsigned T0 = 256u * (8u * g + tq_) + 8u * (tp_ & 1u) + 16u * ((tp_ >> 1) ^ (s0_ & 1u)), T1 = 256u * (8u * g + tq_ + 4u) + 8u * (tp_ & 1u) + 16u * ((tp_ >> 1) ^ (s1_ & 1u));
#define SC_ROWF(img, rb, ks) (*(const LAS bf16x8*)((img) + (RB + 4096u * (rb) + xk[ks])))
#define SC_TRF(img, cc, ks) __builtin_shufflevector(__builtin_amdgcn_ds_read_tr16_b64_v4i16((LAS s16x4*)((img) + (T0 + 8192u * (ks) + 32u * ((unsigned)(cc) ^ u0)))), \
                                                    __builtin_amdgcn_ds_read_tr16_b64_v4i16((LAS s16x4*)((img) + (T1 + 8192u * (ks) + 32u * ((unsigned)(cc) ^ u1)))), 0, 1, 2, 3, 4, 5, 6, 7)
            LAS unsigned char* Lb = L + par * SC_BUF;
            if (prm && K0 < 33 && c == K0 - 1) {
                if (tid == 0) { unsigned* cl = (unsigned*)(F.ctl + CW_LATE); unsigned sp = 0u;
                    while (__hip_atomic_load(cl, __ATOMIC_RELAXED, __HIP_MEMORY_SCOPE_AGENT) < (unsigned)N_HELP) { __builtin_amdgcn_s_sleep(4); if (++sp > (1u << 22)) break; }
                    __builtin_amdgcn_fence(__ATOMIC_ACQUIRE, "agent"); asm volatile("s_waitcnt vmcnt(0)" ::: "memory"); }
                asm volatile("s_waitcnt lgkmcnt(0)" ::: "memory"); __builtin_amdgcn_s_barrier(); asm volatile("" ::: "memory"); }
            v4u gA[4], gB[4];
            if (emit) { const bf16* crow = PROJ + (size_t)cbase * NPROJ + h * DVH;
#pragma unroll
                for (int tt = 0; tt < 4; ++tt)
                    { const unsigned po = (unsigned)(16 * tt + l15) * NPROJ + 32u * w + 8u * g; gA[tt] = *(const v4u*)(crow + (po + C_GA)); gB[tt] = *(const v4u*)(crow + (po + C_GB)); } }
            { const int cn = (c + 1 < nchunk) ? c + 1 : c; SCAN_ISSUE(cn, 0, tc, (par ^ 1)); }
            {
                const int st = w & 3;
#pragma unroll
                for (int tq = 0; tq < 2; ++tq) { const int tt = 2 * (w >> 2) + tq; f32x4 acc = {0.f, 0.f, 0.f, 0.f};
#pragma unroll
                    for (int ks = 0; ks < 4; ++ks) acc = MFMA16(SC_ROWF(Lb + SC_KT, st, ks), SC_ROWF(Lb + SC_QT, tt, ks), acc);
                    const int tabs = 16 * tt + l15, sabs = 16 * st + 4 * g;
                    float m[4];
#pragma unroll
                    for (int e = 0; e < 4; ++e) m[e] = (sabs + e <= tabs) ? acc[e] : 0.f;
                    *(LAS u32x2*)(L + SC_AT + AT_PITCH * tabs + 2 * sabs) = (u32x2){pkbf(m[0], m[1]), pkbf(m[2], m[3])}; }
            }
            bf16x8 vf[2][2];
#pragma unroll
            for (int dt = 0; dt < 2; ++dt)
#pragma unroll
                for (int ks = 0; ks < 2; ++ks) vf[dt][ks] = SC_TRF(Lb + SC_V + (w >> 2) * 16384, 2 * (w & 3) + dt, ks);
            f32x4 o[2][4];
#pragma unroll
            for (int dt = 0; dt < 2; ++dt)
#pragma unroll
                for (int tt = 0; tt < 4; ++tt) o[dt][tt] = (f32x4){0.f, 0.f, 0.f, 0.f};
#pragma unroll
            for (int ks = 0; ks < 4; ++ks) {
                bf16x8 sa[2];
#pragma unroll
                for (int dt = 0; dt < 2; ++dt) { const f32x4 s0 = S[2 * ks][dt], s1 = S[2 * ks + 1][dt];
                    const v4u pk = {pkbf(s0[0], s0[1]), pkbf(s0[2], s0[3]), pkbf(s1[0], s1[1]), pkbf(s1[2], s1[3])}; sa[dt] = __builtin_bit_cast(bf16x8, pk); }
#pragma unroll
                for (int tt = 0; tt < 4; ++tt) { const unsigned t = 16 * tt + l15;
                    const u32x2 lo = *(const LAS u32x2*)(Lb + SC_QT + (Q0 + 4096u * tt + xk[ks])), hi = *(const LAS u32x2*)(Lb + SC_QT + (Q1 + 4096u * tt + xk[ks]));
                    const v4u bq4 = {lo[0], lo[1], hi[0], hi[1]}; const bf16x8 bq = __builtin_bit_cast(bf16x8, bq4);
#pragma unroll
                    for (int dt = 0; dt < 2; ++dt) o[dt][tt] = MFMA16(sa[dt], bq, o[dt][tt]); }
            }
#pragma unroll
            for (int kt = 0; kt < 8; ++kt) {
#pragma unroll
                for (int ks = 0; ks < 2; ++ks) { const bf16x8 ka = SC_TRF(Lb + SC_KT, kt, ks);
#pragma unroll
                    for (int dt = 0; dt < 2; ++dt) S[kt][dt] = MFMA16(ka, vf[dt][ks], S[kt][dt]); }
                const f32x4 e4 = *(const LAS f32x4*)(Lb + SC_EX + (16 * kt + 4 * g) * 4);
#pragma unroll
                for (int dt = 0; dt < 2; ++dt) S[kt][dt] = S[kt][dt] * e4; }
            asm volatile("s_waitcnt lgkmcnt(0)" ::: "memory"); __builtin_amdgcn_s_barrier(); asm volatile("" ::: "memory");
#pragma unroll
            for (int ks = 0; ks < 2; ++ks)
#pragma unroll
                for (int tt = 0; tt < 4; ++tt) { const bf16x8 ba = *(const LAS bf16x8*)(L + SC_AT + AT_PITCH * (16 * tt + l15) + 64 * ks + 16 * g);
#pragma unroll
                    for (int dt = 0; dt < 2; ++dt) o[dt][tt] = MFMA16(vf[dt][ks], ba, o[dt][tt]); }
#pragma unroll
            for (int tt = 0; tt < 4; ++tt) { float ss = pg8::dot4(o[0][tt]) + pg8::dot4(o[1][tt]); ss += __shfl_xor(ss, 16); ss += __shfl_xor(ss, 32);
                if (g == 0) ((LAS float*)(L + SC_RS + par * 2048))[(16 * tt + l15) * 8 + w] = ss; }
            asm volatile("s_waitcnt vmcnt(0) lgkmcnt(0)" ::: "memory"); __builtin_amdgcn_s_barrier(); asm volatile("" ::: "memory");
            if (emit) {
                bf16* mrow = MERGED + (size_t)cbase * D + h * DVH;
#pragma unroll
                for (int tt = 0; tt < 4; ++tt) asm volatile("" : "+v"(gA[tt]), "+v"(gB[tt]));
#pragma unroll
                for (int tt = 0; tt < 4; ++tt) { const int t = 16 * tt + l15;
                    const f32x4 r0 = *(const LAS f32x4*)(L + SC_RS + par * 2048 + t * 32), r1 = *(const LAS f32x4*)(L + SC_RS + par * 2048 + t * 32 + 16);
                    const float rstd = 1.0f / sqrtf((((r0[0] + r0[1]) + (r0[2] + r0[3])) + ((r1[0] + r1[1]) + (r1[2] + r1[3]))) * (1.0f / 256.0f) + 1e-6f);
                    v4u mw;
#pragma unroll
                    for (int dt = 0; dt < 2; ++dt) {
                        float mv[4];
#pragma unroll
                        for (int e = 0; e < 4; ++e) { const unsigned wa = gA[tt][2 * dt + (e >> 1)], wb_ = gB[tt][2 * dt + (e >> 1)];
                            const float ga = (e & 1) ? bfhi(wa) : bflo(wa), mb = (e & 1) ? bfhi(wb_) : bflo(wb_);
                            mv[e] = ga * (o[dt][tt][e] * rstd) + mb; }
                        mw[2 * dt] = pkbf(mv[0], mv[1]); mw[2 * dt + 1] = pkbf(mv[2], mv[3]); }
                    *(v4u*)(mrow + ((unsigned)t * D + 32u * w + 8u * g)) = mw; }
            }
          }
        }
#undef SCAN_ISSUE
#undef SC_ROWF
#undef SC_TRF
        int to = tid; asm volatile("" : "+v"(to));
        { const unsigned l15u = to & 15, gu = (to >> 4) & 3; float* soh = outp + (prm ? OFF_SGP : OFF_SGS) + (size_t)(b * HEADS + h) * DKH * DVH + 32 * w;
#pragma unroll
          for (int kt = 0; kt < 8; ++kt)
#pragma unroll
            for (int dt = 0; dt < 2; ++dt) { const unsigned o0 = (16u * kt + 4u * gu) * DVH + 8u * (l15u >> 2) + 4u * dt + (l15u & 3u);
                soh[o0] = S[kt][dt][0]; soh[o0 + DVH] = S[kt][dt][1]; soh[o0 + 2 * DVH] = S[kt][dt][2]; soh[o0 + 3 * DVH] = S[kt][dt][3]; } }
    }
    __syncthreads();
}

__device__ __forceinline__ void final_norm_phase(Frame& F, const int row_lo, const int row_hi, const int gw, const int NGW, const bf16* h2base) {
    unsigned char* ws_ = KWS(); float* outp = KOUT();
    int ln = F.lane; asm volatile("" : "+v"(ln));
    const float* SS = (const float*)(ws_ + WS_SS3); const GAS f32x4* gr = (const GAS f32x4*)KIN(17) + 2 * ln;
    f32x4 g[2][2];
#pragma unroll
    for (int j = 0; j < 2; ++j) { g[j][0] = gr[128 * j]; g[j][1] = gr[128 * j + 1]; }
    for (int m0 = row_lo + 2 * gw; m0 < row_hi; m0 += 2 * NGW) {
        v4u hw[2][2]; f32x4 sq[2][4];
#pragma unroll
        for (int r = 0; r < 2; ++r) { const int m = m0 + r;
            const GAS v4u* hr = (const GAS v4u*)(h2base + (size_t)(m - row_lo) * D) + ln;
            hw[r][0] = hr[0]; hw[r][1] = hr[64];
            const f32x4* sp = (const f32x4*)(SS + (size_t)m * 16);
#pragma unroll
            for (int q = 0; q < 4; ++q) sq[r][q] = sp[q]; }
#pragma unroll
        for (int r = 0; r < 2; ++r) { const int m = m0 + r;
            GAS f32x4* xr = (GAS f32x4*)(outp + (size_t)m * D) + 2 * ln;
            const f32x4 s4 = (sq[r][0] + sq[r][1]) + (sq[r][2] + sq[r][3]);
            const float rstd = 1.0f / sqrtf(((s4[0] + s4[1]) + (s4[2] + s4[3])) * (1.0f / 1024.0f) + 1e-6f);
#pragma unroll
            for (int j = 0; j < 2; ++j) { const v4u w_ = hw[r][j];
                const f32x4 v0 = {bflo(w_[0]), bfhi(w_[0]), bflo(w_[1]), bfhi(w_[1])}, v1 = {bflo(w_[2]), bfhi(w_[2]), bflo(w_[3]), bfhi(w_[3])};
                __builtin_nontemporal_store(v0 * rstd * g[j][0], &xr[128 * j]); __builtin_nontemporal_store(v1 * rstd * g[j][1], &xr[128 * j + 1]); } }
    }
}

__device__ __forceinline__ void helper_barrier(gu32* cnt, const unsigned target) {
    asm volatile("s_waitcnt vmcnt(0)" ::: "memory");
    __syncthreads();
    if (threadIdx.x == 0) {
        __builtin_amdgcn_fence(__ATOMIC_RELEASE, "agent");
        asm volatile("s_waitcnt vmcnt(0)" ::: "memory");
        (void)__hip_atomic_fetch_add((unsigned*)cnt, 1u, __ATOMIC_RELAXED, __HIP_MEMORY_SCOPE_AGENT);
        unsigned sp = 0u;
        while (__hip_atomic_load((unsigned*)cnt, __ATOMIC_RELAXED, __HIP_MEMORY_SCOPE_AGENT) < target) { __builtin_amdgcn_s_sleep(2); if (++sp > (1u << 22)) break; }
        __builtin_amdgcn_fence(__ATOMIC_ACQUIRE, "agent");
        asm volatile("s_waitcnt vmcnt(0)" ::: "memory");
    }
    __syncthreads();
}
__device__ __forceinline__ void sample_tail(Frame& F) {
    const int hc = F.vcu - (F.G - N_HELP);
    helper_barrier(F.ctl + CW_HBAR, N_HELP);
    {   unsigned char* ws = KWS();
        pg8::Gemm g{(const pg8::bf16_t*)(ws + WS_MERGED) + (size_t)MP * D, (const pg8::bf16_t*)(ws + WS_WOUT), MS, D, D};
        pg8::StaticOrder S; S.init(MS, D, N_HELP, hc);
        pg8::EpiOut E{KIN(1), KIN(1), 1 << 30, KOUT() + (size_t)MP * D, (pg8::bf16_t*)(ws + WS_HBS), (float*)(ws + WS_SS2) + (size_t)MP * 16};
        pg8::gemm_phase<pg8::EpiOut, pg8::StaticOrder, true, true>(F.lds + RING_OFF, g, S, E);
    }
    helper_barrier(F.ctl + CW_HBAR + 64, N_HELP);
    {   unsigned char* ws = KWS();
        pg8::Gemm g{(const pg8::bf16_t*)(ws + WS_HBS), (const pg8::bf16_t*)(ws + WS_WGU), MS, NGU, D};
        pg8::StaticOrder S; S.init(MS, NGU, N_HELP, hc);
        pg8::EpiGU E{(const float*)(ws + WS_SS2) + (size_t)MP * 16, (pg8::bf16_t*)(ws + WS_ACTS), DFF, 0};
        pg8::gemm_phase<pg8::EpiGU, pg8::StaticOrder, true, true>(F.lds + RING_OFF, g, S, E);
    }
    helper_barrier(F.ctl + CW_HBAR + 128, N_HELP);
    {   unsigned char* ws = KWS();
        pg8::Gemm g{(const pg8::bf16_t*)(ws + WS_ACTS), (const pg8::bf16_t*)(ws + WS_WDN), MS, D, DFF};
        pg8::SplitKOrder S; S.init(MS, D, N_HELP, hc);
        pg8::EpiPart E{(float*)(ws + WS_PART), MS};
        pg8::gemm_phase<pg8::EpiPart, pg8::SplitKOrder, true, true>(F.lds + RING_OFF, g, S, E);
    }
    helper_barrier(F.ctl + CW_HBAR + 192, N_HELP);
    {   unsigned char* ws_ = KWS(); float* outp = KOUT();
        int ln = F.lane; asm volatile("" : "+v"(ln));
        const GAS f32x4* gr = (const GAS f32x4*)KIN(17) + 2 * ln;
        for (int m = hc * NWAVES + F.wave; m < MS; m += N_HELP * NWAVES) {
            const GAS v4u* hr = (const GAS v4u*)((const bf16*)(ws_ + WS_HBS) + (size_t)m * D) + ln;
            f32x4 v[2][2];
#pragma unroll
            for (int j = 0; j < 2; ++j) { const v4u w_ = hr[64 * j];
                v[j][0] = (f32x4){bflo(w_[0]), bfhi(w_[0]), bflo(w_[1]), bfhi(w_[1])}; v[j][1] = (f32x4){bflo(w_[2]), bfhi(w_[2]), bflo(w_[3]), bfhi(w_[3])}; }
#pragma unroll
            for (int q = 0; q < 4; ++q) { const GAS f32x4* pr = (const GAS f32x4*)((const float*)(ws_ + WS_PART) + ((size_t)q * MS + m) * D) + 2 * ln;
#pragma unroll
                for (int j = 0; j < 2; ++j) { v[j][0] += pr[128 * j]; v[j][1] += pr[128 * j + 1]; } }
            float ss = 0.f;
#pragma unroll
            for (int j = 0; j < 2; ++j) ss += pg8::dot4(v[j][0]) + pg8::dot4(v[j][1]);
            const float rstd = 1.0f / sqrtf(wave_sum(ss) * (1.0f / 1024.0f) + 1e-6f);
            GAS f32x4* xr = (GAS f32x4*)(outp + (size_t)(MP + m) * D) + 2 * ln;
#pragma unroll
            for (int j = 0; j < 2; ++j) { xr[128 * j] = v[j][0] * rstd * gr[128 * j]; xr[128 * j + 1] = v[j][1] * rstd * gr[128 * j + 1]; }
        }
    }
}

__device__ __forceinline__ int build_rstd_table(Frame& F, const pg8::StaticOrder& S, const float* SS) {
    LAS float* tab = (LAS float*)(F.lds + TAB_OFF); LAS int* tg = (LAS int*)(tab + 8 * 256);
    __syncthreads();
    if (F.tid < 8) tg[F.tid] = -1;
    __syncthreads();
    int n = 0, lastpm = -1;
    for (int i = 0; ; ++i) { pg8::Unit u; if (!S.next(i, u)) break;
        if (u.pm == lastpm) continue;
        if (n == 8) { n = 9; break; }
        if (F.tid < 256) { const f32x4* sp = (const f32x4*)(SS + (size_t)(u.pm * 256 + F.tid) * 16); const f32x4 s4 = (sp[0] + sp[1]) + (sp[2] + sp[3]);
            tab[n * 256 + F.tid] = __builtin_amdgcn_rsqf(((s4[0] + s4[1]) + (s4[2] + s4[3])) * (1.0f / 1024.0f) + pg8::RMS_EPS); }
        if (F.tid == 0) tg[n] = u.pm;
        ++n; lastpm = u.pm; }
    __syncthreads();
    return n <= 8 ? n : 0;
}

__global__ void __launch_bounds__(NWAVES * 64, 2) fwd_mega(Args args) {
    extern __shared__ __attribute__((aligned(16))) unsigned char lds[];
    Frame F;
    F.lds = (LAS unsigned char*)lds;
    F.MISC = (volatile LAS unsigned*)(F.lds + MISC_OFF);
    F.tid = threadIdx.x; F.lane = F.tid & 63; F.wave = __builtin_amdgcn_readfirstlane(F.tid >> 6);
    F.G = gridDim.x; { const int bx = blockIdx.x; F.vcu = (F.G % 8 == 0) ? (bx % 8) * (F.G / 8) + bx / 8 : bx; }
    F.ctl = (gu32*)(KWS() + WS_CTL);
    for (int u = F.tid; u < (LDS_BYTES - LDSCTL_OFF) / 4; u += NWAVES * 64) ((LAS unsigned*)(F.lds + LDSCTL_OFF))[u] = 0u;
    __syncthreads();
    XcdBarrier bar = xcd_barrier_post((unsigned*)(F.ctl + CW_BAR), F.MISC + 8);
#define GRID_BAR() xcd_barrier(bar)
    p0_prologue(F);
    GRID_BAR();
    {   unsigned char* ws = KWS();
        pg8::Gemm g{(const pg8::bf16_t*)(ws + WS_XN), (const pg8::bf16_t*)(ws + WS_WIN), MIN_ROWS, NIN, D};
        pg8::StaticOrder S; S.init(MIN_ROWS, NIN, F.G, (int)blockIdx.x);
        LAS float* gt = (LAS float*)(F.lds + TAB_OFF);
        { const f32x4 v = (F.tid < 256) ? ((const f32x4*)KIN(9))[F.tid] : ((const f32x4*)KIN(11))[F.tid - 256]; ((LAS f32x4*)gt)[F.tid] = v; }
        __syncthreads();
        pg8::EpiProj E{(pg8::bf16_t*)(ws + WS_PROJ), NPROJ, (float*)(ws + WS_ALR)};
        pg8::gemm_phase<pg8::EpiProj, pg8::StaticOrder, true, true>(F.lds + RING_OFF, g, S, E);
    }
    {
        const int nwg1 = (MIN_ROWS / 256) * (NIN / 256), rem = nwg1 % F.G, c = (int)blockIdx.x;
        const int ne = rem == 0 ? F.G : F.G - rem, e = rem == 0 ? c : c - rem;
        if (e >= 0) late_weight_items(F, e, ne);
    }
    GRID_BAR();
    const bool split = (F.G == 256);
    const int K0 = split ? 21 : 33;
    gla_prep_qk(F, 0, K0, true, F.wave * F.G + F.vcu, F.G * NWAVES);
    gla_prep_pool(F, 0, 4 * (K0 - 1), true, F.wave * (F.G >> 2) + (F.vcu >> 2), (F.G >> 2) * NWAVES);
    GRID_BAR();
    gla_scan(F, K0);
    if (split && F.vcu >= F.G - N_HELP) {
        const int hc = F.vcu - (F.G - N_HELP);
        gla_prep_qk(F, K0, 33, false, F.wave * N_HELP + hc, N_HELP * NWAVES);
        gla_prep_pool(F, 4 * (K0 - 1), 128, false, F.wave * (N_HELP >> 2) + (hc >> 2), (N_HELP >> 2) * NWAVES);
        asm volatile("s_waitcnt vmcnt(0)" ::: "memory");
        __syncthreads();
        if (F.tid == 0) { __builtin_amdgcn_fence(__ATOMIC_RELEASE, "agent"); asm volatile("s_waitcnt vmcnt(0)" ::: "memory"); (void)__hip_atomic_fetch_add((unsigned*)(F.ctl + CW_LATE), 1u, __ATOMIC_RELAXED, __HIP_MEMORY_SCOPE_AGENT); }
    }
    const int MROWS = (F.G == 256) ? MP : MO;
    if (F.G == 256 && F.vcu >= F.G - N_HELP) sample_tail(F);
    GRID_BAR();
    {   unsigned char* ws = KWS();
        pg8::Gemm g{(const pg8::bf16_t*)(ws + WS_MERGED), (const pg8::bf16_t*)(ws + WS_WOUT), MROWS, D, D};
        pg8::StaticOrder S; S.init(MROWS, D, F.G, (int)blockIdx.x);
        pg8::EpiOut E{KIN(0), KIN(1), MP, KOUT(), (pg8::bf16_t*)(ws + WS_HB), (float*)(ws + WS_SS2)};
        pg8::gemm_phase<pg8::EpiOut, pg8::StaticOrder, true, true>(F.lds + RING_OFF, g, S, E);
    }
    GRID_BAR();
    {   unsigned char* ws = KWS();
        pg8::Gemm g{(const pg8::bf16_t*)(ws + WS_HB), (const pg8::bf16_t*)(ws + WS_WGU), MROWS, NGU, D};
        pg8::StaticOrder S; S.init(MROWS, NGU, F.G, (int)blockIdx.x);
        const int ntab = build_rstd_table(F, S, (const float*)(ws + WS_SS2));
        pg8::EpiGU E{(const float*)(ws + WS_SS2), (pg8::bf16_t*)(ws + WS_ACT), DFF, ntab};
        pg8::gemm_phase<pg8::EpiGU, pg8::StaticOrder, true, true>(F.lds + RING_OFF, g, S, E);
    }
    GRID_BAR();
    {   unsigned char* ws = KWS();
        pg8::Gemm g{(const pg8::bf16_t*)(ws + WS_ACT), (const pg8::bf16_t*)(ws + WS_WDN), MROWS, D, DFF};
        pg8::StaticOrder S; S.init(MROWS, D, F.G, (int)blockIdx.x);
        pg8::EpiDown E{(float*)(ws + WS_SS3), (pg8::bf16_t*)(ws + WS_HB)};
        pg8::gemm_phase<pg8::EpiDown, pg8::StaticOrder, true, true>(F.lds + RING_OFF, g, S, E);
    }
    GRID_BAR();
    final_norm_phase(F, 0, MROWS, F.vcu * NWAVES + F.wave, F.G * NWAVES, (const bf16*)(KWS() + WS_HB));
}

extern "C" void kernel_launch(void* const* d_in, const int* in_sizes, int n_in, void* d_out, int out_size, void* d_ws, size_t ws_size, hipStream_t stream) {
    static int grid = 0;
    if (grid == 0) {
        if (n_in != 18 || ws_size < WS_END) { fprintf(stderr, "kernel_launch: needs 18 inputs and >= %zu bytes of workspace; got n_in %d, ws %zu; nothing launched\n", (size_t)WS_END, n_in, ws_size); grid = -1; return; }
        int dev = 0, cus = 0, per_cu = 0;
        if (hipGetDevice(&dev) != hipSuccess || hipDeviceGetAttribute(&cus, hipDeviceAttributeMultiprocessorCount, dev) != hipSuccess) { grid = -1; return; }
        if (hipFuncSetAttribute((const void*)fwd_mega, hipFuncAttributeMaxDynamicSharedMemorySize, LDS_BYTES) != hipSuccess) { fprintf(stderr, "kernel_launch: hipFuncSetAttribute failed\n"); grid = -1; return; }
        if (hipOccupancyMaxActiveBlocksPerMultiprocessor(&per_cu, (const void*)fwd_mega, NWAVES * 64, LDS_BYTES) != hipSuccess || per_cu < 1) { fprintf(stderr, "kernel_launch: occupancy query reports %d\n", per_cu); }
        (void)hipGetLastError();
        grid = cus;
    }
    if (grid < 0) return;
    if (hipMemsetAsync((char*)d_ws + WS_CTL, 0, CTL_ZERO_BYTES, stream) != hipSuccess) { fprintf(stderr, "kernel_launch: memset failed\n"); return; }
    Args a{};
    for (int i = 0; i < 18; ++i) a.in[i] = (const float*)d_in[i];
    a.out = (float*)d_out; a.ws = (unsigned char*)d_ws;
    hipLaunchKernelGGL(fwd_mega, dim3(grid), dim3(NWAVES * 64), LDS_BYTES, stream, a);
}
```

```cpp
#include <hip/hip_runtime.h>
#include <cstdio>
#include <cstdint>
namespace pg8 {
#define PG8_LAS __attribute__((address_space(3)))
typedef unsigned short bf16_t;
typedef short bf16x8 __attribute__((ext_vector_type(8)));
typedef float f32x4 __attribute__((ext_vector_type(4)));
typedef unsigned u32x4 __attribute__((ext_vector_type(4)));
constexpr int BM = 256, BK = 64, HALF = 128, HTB = HALF * BK * 2  , STAGE_BYTES = 8 * HTB, NXCD = 8, WGM = 4;

__host__ __device__ __forceinline__ int lds_byte(int r, int c) { const int st = (r >> 4) * 2 + (c >> 5), rr = r & 15, cc = c & 31, ob = rr * 64 + cc * 2; return st * 1024 + (ob ^ (((ob >> 9) & 1) << 5)); }
__host__ __device__ __forceinline__ void stage_rc(int b, int& R, int& C) { const int st = b / 1024, sb = b % 1024, swz = sb ^ (((sb >> 9) & 1) << 5); R = (st >> 1) * 16 + swz / 64; C = (st & 1) * 32 + (swz % 64) / 2; }
__host__ __device__ __forceinline__ int perm32(int rho) { const int n = rho >> 4, i = rho & 15; return 8 * (i >> 2) + 4 * n + (i & 3); }

struct Unit { int pm, pn, k0, nkt, ks; };
struct Gemm { const bf16_t* A; const bf16_t* Bt; int M, N, K; };

struct StaticOrder {
    static constexpr bool SPLITK = false;
    int nM, nN, nwg, G, c;
    __host__ __device__ void init(int M, int N, int G_, int c_) { nM = M / BM; nN = N / BM; nwg = nM * nN; G = G_; c = c_; }
    __host__ __device__ bool next(int i, Unit& u) const {
        const long L = (long)i * G + c; if (L >= nwg) return false;
        int wgid = (int)L; { const int q = nwg / NXCD, r = nwg % NXCD, xcd = wgid % NXCD, off = wgid / NXCD; wgid = (xcd < r ? xcd * (q + 1) : r * (q + 1) + (xcd - r) * q) + off; }
        const int nig = WGM * nN, gid = wgid / nig, fm = gid * WGM, gsz = (nM - fm) < WGM ? (nM - fm) : WGM;
        u.pm = fm + ((wgid % nig) % gsz); u.pn = (wgid % nig) / gsz; return true;
    }
    __device__ __forceinline__ void a_ready(const Unit&) const {}
    __device__ __forceinline__ void done(const Unit&) const {}
};

struct SplitKOrder {
    static constexpr bool SPLITK = true;
    int nM, nN, total, G, c;
    __host__ __device__ void init(int M, int N, int G_, int c_) { nM = M / BM; nN = N / BM; total = nM * nN * 4; G = G_; c = c_; }
    __host__ __device__ bool next(int i, Unit& u) const {
        const long L = (long)i * G + c; if (L >= total) return false;
        const int tile = (int)L >> 2, ks = (int)L & 3;
        u.pm = tile % nM; u.pn = tile / nM; u.ks = ks; u.k0 = ks < 2 ? 12 * ks : 24 + 10 * (ks - 2); u.nkt = ks < 2 ? 12 : 10; return true;
    }
    __device__ __forceinline__ void a_ready(const Unit&) const {}
    __device__ __forceinline__ void done(const Unit&) const {}
};

__device__ __forceinline__ unsigned cvt_pk_bf16(float lo, float hi) { unsigned r; asm volatile("v_cvt_pk_bf16_f32 %0, %1, %2" : "=v"(r) : "v"(lo), "v"(hi)); return r; }
typedef float f32x2 __attribute__((ext_vector_type(2)));
typedef unsigned u32x2 __attribute__((ext_vector_type(2)));
constexpr float RMS_EPS = 1e-6f;
__device__ __forceinline__ float fast_exp(float x) { return __builtin_amdgcn_exp2f(x * 1.44269504089f); }
__device__ __forceinline__ float fast_sigmoid(float x) { return __builtin_amdgcn_rcpf(1.0f + fast_exp(-x)); }
__device__ __forceinline__ float dot4(const f32x4 a) { return (a[0] * a[0] + a[1] * a[1]) + (a[2] * a[2] + a[3] * a[3]); }
__device__ __forceinline__ u32x4 pack8(const f32x4 v0, const f32x4 v1) { u32x4 w; w.x = cvt_pk_bf16(v0[0], v0[1]); w.y = cvt_pk_bf16(v0[2], v0[3]); w.z = cvt_pk_bf16(v1[0], v1[1]); w.w = cvt_pk_bf16(v1[2], v1[3]); return w; }

struct EpiProj {
    static constexpr bool PERM = true, AFTER_DRAIN = false;
    bf16_t* O; int ldc; float* ALR;
    __device__ __forceinline__ void operator()(const f32x4 (&acc)[2][2][4][2], const Unit& u, int wr, int wc, int fr, int fq, const PG8_LAS unsigned char* side) const {
        bf16_t* tb = O + (size_t)(u.pm * BM) * ldc;
        unsigned off = (unsigned)(wr * 64 + fr) * (unsigned)ldc + (unsigned)(wc * 32 + 8 * fq);
        if (u.pn == 22) {
            if (wc == 0 && fq < 2) {
#pragma unroll
                for (int ai = 0; ai < 2; ++ai)
#pragma unroll
                    for (int m = 0; m < 4; ++m) { float* ap = ALR + (size_t)(u.pm * BM + wr * 64 + fr + ai * HALF + m * 16) * 16 + 8 * fq; *(f32x4*)ap = acc[ai][0][m][0]; *(f32x4*)(ap + 4) = acc[ai][0][m][1]; }
            }
        } else if (u.pn < 10) {
            off += (unsigned)(u.pn * BM);
#pragma unroll
            for (int ai = 0; ai < 2; ++ai)
#pragma unroll
                for (int m = 0; m < 4; ++m) { asm volatile("" : "+v"(off));
#pragma unroll
                    for (int bj = 0; bj < 2; ++bj) __builtin_nontemporal_store(pack8(acc[ai][bj][m][0], acc[ai][bj][m][1]), (u32x4*)(tb + (off + bj * HALF)));
                    off += (m == 3 ? 80u : 16u) * (unsigned)ldc; }
        } else if (u.pn < 18) {
            const int cl = (u.pn - 10) * HALF + wc * 32 + 8 * fq;
            const f32x4 g0 = *(const PG8_LAS f32x4*)(side + 4 * cl), g1 = *(const PG8_LAS f32x4*)(side + 4 * cl + 16);
            off += 2560u + (unsigned)((u.pn - 10) * HALF);
#pragma unroll
            for (int ai = 0; ai < 2; ++ai)
#pragma unroll
                for (int m = 0; m < 4; ++m) { f32x4 rr0 = acc[ai][0][m][0], rr1 = acc[ai][0][m][1], qq0 = acc[ai][1][m][0], qq1 = acc[ai][1][m][1];
                    asm volatile("" : "+v"(off), "+v"(rr0), "+v"(rr1), "+v"(qq0), "+v"(qq1));
                    f32x4 a[2];
#pragma unroll
                    for (int j = 0; j < 4; ++j) { const float r0 = rr0[j], r1 = rr1[j];
                        a[0][j] = r0 * g0[j] * __builtin_amdgcn_rcpf((1.0f + fast_exp(-r0)) * (1.0f + fast_exp(-qq0[j]))); a[1][j] = r1 * g1[j] * __builtin_amdgcn_rcpf((1.0f + fast_exp(-r1)) * (1.0f + fast_exp(-qq1[j]))); }
                    __builtin_nontemporal_store(pack8(a[0], a[1]), (u32x4*)(tb + off)); off += (m == 3 ? 80u : 16u) * (unsigned)ldc; __builtin_amdgcn_sched_barrier(0); }
        } else {
            const int cl = (u.pn - 18) * BM + wc * 32 + 8 * fq;
            off += 3584u + (unsigned)((u.pn - 18) * BM);
            const PG8_LAS unsigned char* ps = side + 4096 + 4 * cl;
            const f32x4 p00 = *(const PG8_LAS f32x4*)(ps), p01 = *(const PG8_LAS f32x4*)(ps + 16), p10 = *(const PG8_LAS f32x4*)(ps + 4 * HALF), p11 = *(const PG8_LAS f32x4*)(ps + 4 * HALF + 16);
#pragma unroll
            for (int ai = 0; ai < 2; ++ai)
#pragma unroll
                for (int m = 0; m < 4; ++m) { f32x4 x00 = acc[ai][0][m][0], x01 = acc[ai][0][m][1], x10 = acc[ai][1][m][0], x11 = acc[ai][1][m][1];
                    asm volatile("" : "+v"(off), "+v"(x00), "+v"(x01), "+v"(x10), "+v"(x11));
#pragma unroll
                    for (int bj = 0; bj < 2; ++bj) { f32x4 a[2];
#pragma unroll
                        for (int j = 0; j < 4; ++j) { a[0][j] = fast_sigmoid(bj ? x10[j] : x00[j]) * (bj ? p10[j] : p00[j]); a[1][j] = fast_sigmoid(bj ? x11[j] : x01[j]) * (bj ? p11[j] : p01[j]); }
                        __builtin_nontemporal_store(pack8(a[0], a[1]), (u32x4*)(tb + (off + bj * HALF))); }
                    off += (m == 3 ? 80u : 16u) * (unsigned)ldc; __builtin_amdgcn_sched_barrier(0); }
        }
    }
};
struct EpiOut {
    static constexpr bool PERM = true, AFTER_DRAIN = false;
    const float* xp; const float* xs; int n_prompt_rows; float* out; bf16_t* HB; float* SS;
    __device__ __forceinline__ void operator()(const f32x4 (&acc)[2][2][4][2], const Unit& u, int wr, int wc, int fr, int fq, const PG8_LAS unsigned char* side) const {
        const int row0 = u.pm * BM + wr * 64 + fr, col0 = u.pn * BM + wc * 32 + 8 * fq;
        const bool prm = (u.pm * BM) < n_prompt_rows;
#pragma unroll
        for (int ai = 0; ai < 2; ++ai)
#pragma unroll
            for (int m = 0; m < 4; ++m) { const int row = row0 + ai * HALF + m * 16;
                const float* xr = prm ? xp + (size_t)row * 1024 : xs + (size_t)(row - n_prompt_rows) * 1024;
                float ss = 0.f;
#pragma unroll
                for (int bj = 0; bj < 2; ++bj) { const int c = col0 + bj * HALF;
                    const f32x4 h0 = *(const f32x4*)(xr + c) + acc[ai][bj][m][0], h1 = *(const f32x4*)(xr + c + 4) + acc[ai][bj][m][1];
                    *(u32x4*)(HB + (size_t)row * 1024 + c) = pack8(h0, h1);
                    ss += dot4(h0) + dot4(h1); }
                ss += __shfl_xor(ss, 16); ss += __shfl_xor(ss, 32);
                if (fq == 0) SS[(size_t)row * 16 + u.pn * 4 + wc] = ss; }
    }
};
struct EpiGU {
    static constexpr bool PERM = true, AFTER_DRAIN = false;
    const float* SS; bf16_t* ACT; int ldact;
    int ntab;
    __device__ __forceinline__ void operator()(const f32x4 (&acc)[2][2][4][2], const Unit& u, int wr, int wc, int fr, int fq, const PG8_LAS unsigned char* side) const {
        const int row0 = u.pm * BM + wr * 64 + fr, col0 = u.pn * HALF + wc * 32 + 8 * fq;
        if (ntab > 0) {
            const PG8_LAS float* tab = (const PG8_LAS float*)side; const PG8_LAS int* tg = (const PG8_LAS int*)(tab + 8 * 256);
            int slot = 0;
#pragma unroll
            for (int q = 1; q < 8; ++q) if (tg[q] == u.pm) slot = q;
            const PG8_LAS float* tr = tab + slot * 256 + wr * 64 + fr;
#pragma unroll
            for (int ai = 0; ai < 2; ++ai)
#pragma unroll
                for (int m = 0; m < 4; ++m) { const int row = row0 + ai * HALF + m * 16;
                    const float rstd = tr[ai * HALF + m * 16];
                    const f32x2 nrl = {rstd * -1.44269504089f, rstd * -1.44269504089f}, r2 = {rstd * rstd, rstd * rstd}, one = {1.0f, 1.0f};
                    f32x4 a[2];
#pragma unroll
                    for (int n = 0; n < 2; ++n)
#pragma unroll
                        for (int j = 0; j < 4; j += 2) { const f32x2 ag = {acc[ai][0][m][n][j], acc[ai][0][m][n][j + 1]}, au = {acc[ai][1][m][n][j], acc[ai][1][m][n][j + 1]};
                            const f32x2 t = ag * nrl; const f32x2 d = (f32x2){__builtin_amdgcn_exp2f(t[0]), __builtin_amdgcn_exp2f(t[1])} + one;
                            const f32x2 q = {__builtin_amdgcn_rcpf(d[0]), __builtin_amdgcn_rcpf(d[1])}; const f32x2 r = ((ag * au) * r2) * q;
                            a[n][j] = r[0]; a[n][j + 1] = r[1]; }
                    __builtin_nontemporal_store(pack8(a[0], a[1]), (u32x4*)(ACT + (size_t)row * ldact + col0)); }
        } else {
#pragma unroll
            for (int ai = 0; ai < 2; ++ai)
#pragma unroll
                for (int m = 0; m < 4; ++m) { const int row = row0 + ai * HALF + m * 16;
                    const f32x4* sp = (const f32x4*)(SS + (size_t)row * 16);
                    const f32x4 s4 = (sp[0] + sp[1]) + (sp[2] + sp[3]);
                    const float rstd = __builtin_amdgcn_rsqf(((s4[0] + s4[1]) + (s4[2] + s4[3])) * (1.0f / 1024.0f) + RMS_EPS);
                    f32x4 a[2];
#pragma unroll
                    for (int n = 0; n < 2; ++n)
#pragma unroll
                        for (int j = 0; j < 4; ++j) { const float g = acc[ai][0][m][n][j] * rstd, up = acc[ai][1][m][n][j] * rstd; a[n][j] = g * up * fast_sigmoid(g); }
                    __builtin_nontemporal_store(pack8(a[0], a[1]), (u32x4*)(ACT + (size_t)row * ldact + col0)); }
        }
    }
};
struct EpiDown {
    static constexpr bool PERM = true, AFTER_DRAIN = false;
    float* SS; bf16_t* HB;
    __device__ __forceinline__ void operator()(const f32x4 (&acc)[2][2][4][2], const Unit& u, int wr, int wc, int fr, int fq, const PG8_LAS unsigned char* side) const {
        const int row0 = u.pm * BM + wr * 64 + fr, col0 = u.pn * BM + wc * 32 + 8 * fq;
#pragma unroll
        for (int ai = 0; ai < 2; ++ai)
#pragma unroll
            for (int m = 0; m < 4; ++m) { const int row = row0 + ai * HALF + m * 16;
                float ss = 0.f;
#pragma unroll
                for (int bj = 0; bj < 2; ++bj) { bf16_t* hp = HB + (size_t)row * 1024 + col0 + bj * HALF;
                    const u32x4 hw = *(const u32x4*)hp;
                    const f32x4 r0 = {__builtin_bit_cast(float, hw.x << 16), __builtin_bit_cast(float, hw.x & 0xffff0000u), __builtin_bit_cast(float, hw.y << 16), __builtin_bit_cast(float, hw.y & 0xffff0000u)};
                    const f32x4 r1 = {__builtin_bit_cast(float, hw.z << 16), __builtin_bit_cast(float, hw.z & 0xffff0000u), __builtin_bit_cast(float, hw.w << 16), __builtin_bit_cast(float, hw.w & 0xffff0000u)};
                    const f32x4 h0 = r0 + acc[ai][bj][m][0], h1 = r1 + acc[ai][bj][m][1];
                    *(u32x4*)hp = pack8(h0, h1);
                    ss += dot4(h0) + dot4(h1); }
                ss += __shfl_xor(ss, 16); ss += __shfl_xor(ss, 32);
                if (fq == 0) SS[(size_t)row * 16 + u.pn * 4 + wc] = ss; }
    }
};
struct EpiPart {
    static constexpr bool PERM = true, AFTER_DRAIN = false;
    float* P; int M;
    __device__ __forceinline__ void operator()(const f32x4 (&acc)[2][2][4][2], const Unit& u, int wr, int wc, int fr, int fq, const PG8_LAS unsigned char* side) const {
        float* pb = P + (size_t)u.ks * M * 1024;
        const int row0 = u.pm * BM + wr * 64 + fr, col0 = u.pn * BM + wc * 32 + 8 * fq;
#pragma unroll
        for (int ai = 0; ai < 2; ++ai)
#pragma unroll
            for (int m = 0; m < 4; ++m) { const int row = row0 + ai * HALF + m * 16;
#pragma unroll
                for (int bj = 0; bj < 2; ++bj) { float* p = pb + (size_t)row * 1024 + col0 + bj * HALF; *(f32x4*)p = acc[ai][bj][m][0]; *(f32x4*)(p + 4) = acc[ai][bj][m][1]; } }
    }
};
template <class Epi, class Sched, bool ALIGN_EPI = false, bool SP2 = false>
__device__ __forceinline__ void gemm_phase(PG8_LAS unsigned char* lds, const Gemm g, const Sched& S, const Epi& E) {
    int tid_ = threadIdx.x; asm volatile("" : "+v"(tid_));
    const int tid = tid_, wid = __builtin_amdgcn_readfirstlane(tid >> 6), lane = tid & 63, wr = wid >> 2, wc = wid & 3, fr = lane & 15, fq = lane >> 4;
    const int K = g.K, nt = K / BK;
    unsigned voffA[2], voffB[2];
#pragma unroll
    for (int i = 0; i < 2; ++i) { int R, C; stage_rc(tid * 16 + i * 8192, R, C); const int Rb = Epi::PERM ? ((R & ~31) + perm32(R & 31)) : R;
        voffA[i] = (unsigned)(R * K + C) * 2u; voffB[i] = (unsigned)(Rb * K + C) * 2u; }
    const size_t kstep = (size_t)(BK * 2);
    const size_t hstep = (size_t)HALF * K * 2;
    const size_t tstep = 2 * hstep;
    const unsigned ldsw = (unsigned)wid * 1024u;
    const int aoff = lds_byte(wr * 64 + fr, fq * 8), boff = lds_byte(wc * 32 + fr, fq * 8);
#define PG8_SA(b, h) (((b) * 2 + (h)) * HTB)
#define PG8_SB(b, h) ((4 + (b) * 2 + (h)) * HTB)
#define PG8_STAGE(bufoff, gbase, voff) do { _Pragma("unroll") for (int _i = 0; _i < 2; ++_i) \
        __builtin_amdgcn_global_load_lds((const unsigned*)((const char*)(gbase) + (voff)[_i]), (PG8_LAS unsigned*)(lds + (bufoff) + ldsw + _i * 8192), 16, 0, 0); } while (0)
#define PG8_LDA(dst, b, h) do { _Pragma("unroll") for (int m = 0; m < 4; ++m) _Pragma("unroll") for (int k = 0; k < 2; ++k) dst[m][k] = *(const PG8_LAS bf16x8*)(lds + PG8_SA(b, h) + aoff + m * 2048 + k * 1024); } while (0)
#define PG8_LDB(dst, b, h) do { _Pragma("unroll") for (int n = 0; n < 2; ++n) _Pragma("unroll") for (int k = 0; k < 2; ++k) dst[n][k] = *(const PG8_LAS bf16x8*)(lds + PG8_SB(b, h) + boff + n * 2048 + k * 1024); } while (0)
#define PG8_MMA(ai, bj, At, Bt) do { __builtin_amdgcn_s_setprio(1); _Pragma("unroll") for (int m = 0; m < 4; ++m) _Pragma("unroll") for (int n = 0; n < 2; ++n) _Pragma("unroll") for (int k = 0; k < 2; ++k) \
        acc[ai][bj][m][n] = __builtin_amdgcn_mfma_f32_16x16x32_bf16(Bt[n][k], At[m][k], acc[ai][bj][m][n], 0, 0, 0); __builtin_amdgcn_s_setprio(0); } while (0)
#define PG8_WAIT_V(n) asm volatile("s_waitcnt vmcnt(" #n ")" ::: "memory")
#define PG8_WAIT_L(n) asm volatile("s_waitcnt lgkmcnt(" #n ")" ::: "memory")
#define PG8_BAR __builtin_amdgcn_s_barrier()
#define PG8_SCHED __builtin_amdgcn_sched_barrier(0)
    Unit cur, nxt; int ui = 0;
    if (!S.next(0, cur)) return;
    f32x4 acc[2][2][4][2];
#pragma unroll
    for (int a = 0; a < 2; ++a)
#pragma unroll
        for (int b = 0; b < 2; ++b)
#pragma unroll
            for (int m = 0; m < 4; ++m)
#pragma unroll
                for (int n = 0; n < 2; ++n) acc[a][b][m][n] = (f32x4){0.f, 0.f, 0.f, 0.f};
    bf16x8 At[4][2], B0[2][2], B1[2][2];
    const char* cA = (const char*)g.A + (size_t)cur.pm * tstep; const char* cB = (const char*)g.Bt + (size_t)cur.pn * tstep;
    if constexpr (Sched::SPLITK) { cA += (size_t)cur.k0 * kstep; cB += (size_t)cur.k0 * kstep; }
    S.a_ready(cur);
    if constexpr (SP2) {
        PG8_STAGE(PG8_SB(0, 0), cB, voffB); PG8_STAGE(PG8_SB(0, 1), cB + hstep, voffB); PG8_STAGE(PG8_SA(0, 0), cA, voffA); PG8_STAGE(PG8_SA(0, 1), cA + hstep, voffA);
        if (wr == 1) PG8_BAR;
        PG8_WAIT_V(2); PG8_BAR;
        PG8_STAGE(PG8_SB(1, 0), cB + kstep, voffB); PG8_STAGE(PG8_SA(1, 0), cA + kstep, voffA); PG8_STAGE(PG8_SB(1, 1), cB + hstep + kstep, voffB);
        PG8_WAIT_V(6); PG8_BAR;
    } else {
        PG8_STAGE(PG8_SB(0, 0), cB, voffB); PG8_STAGE(PG8_SA(0, 0), cA, voffA); PG8_STAGE(PG8_SB(0, 1), cB + hstep, voffB); PG8_STAGE(PG8_SA(0, 1), cA + hstep, voffA);
        if (wr == 1) PG8_BAR;
        PG8_WAIT_V(4); PG8_BAR;
        PG8_STAGE(PG8_SB(1, 0), cB + kstep, voffB); PG8_STAGE(PG8_SA(1, 0), cA + kstep, voffA); PG8_STAGE(PG8_SB(1, 1), cB + hstep + kstep, voffB);
        PG8_WAIT_V(6); PG8_BAR;
    }
    for (;;) {
        const bool has_next = S.next(ui + 1, nxt);
        const char* nA = has_next ? (const char*)g.A + (size_t)nxt.pm * tstep : cA; const char* nB = has_next ? (const char*)g.Bt + (size_t)nxt.pn * tstep : cB;
        if constexpr (Sched::SPLITK) { if (has_next) { nA += (size_t)nxt.k0 * kstep; nB += (size_t)nxt.k0 * kstep; } }
        const int ntc = Sched::SPLITK ? cur.nkt : nt;
        for (int t = 0; t < ntc; t += 2) {
            const bool last = (t == ntc - 2);
            const char* a1 = cA + (size_t)(t + 1) * kstep;
            const char* a2 = last ? nA : cA + (size_t)(t + 2) * kstep; const char* b2 = last ? nB : cB + (size_t)(t + 2) * kstep;
            const char* a3 = a2 + kstep; const char* b3 = b2 + kstep;
            if (last && has_next) S.a_ready(nxt);
            if constexpr (SP2) {
            PG8_LDB(B0, 0, 0); PG8_LDB(B1, 0, 1); PG8_SCHED; PG8_LDA(At, 0, 0); PG8_STAGE(PG8_SA(1, 1), a1 + hstep, voffA);
            PG8_WAIT_V(8); PG8_WAIT_L(0); PG8_BAR; PG8_MMA(0, 0, At, B0); PG8_MMA(0, 1, At, B1); PG8_BAR; PG8_SCHED;
            PG8_LDA(At, 0, 1); PG8_STAGE(PG8_SB(0, 0), b2, voffB); PG8_STAGE(PG8_SB(0, 1), b2 + hstep, voffB); PG8_STAGE(PG8_SA(0, 0), a2, voffA);
            PG8_WAIT_V(8); PG8_WAIT_L(0); PG8_BAR; PG8_MMA(1, 0, At, B0); PG8_MMA(1, 1, At, B1); PG8_BAR; PG8_SCHED;
            PG8_LDB(B0, 1, 0); PG8_LDB(B1, 1, 1); PG8_SCHED; PG8_LDA(At, 1, 0); PG8_STAGE(PG8_SA(0, 1), a2 + hstep, voffA);
            PG8_WAIT_V(8); PG8_WAIT_L(0); PG8_BAR; PG8_MMA(0, 0, At, B0); PG8_MMA(0, 1, At, B1); PG8_BAR; PG8_SCHED;
            PG8_LDA(At, 1, 1); PG8_STAGE(PG8_SB(1, 0), b3, voffB); PG8_STAGE(PG8_SB(1, 1), b3 + hstep, voffB); PG8_STAGE(PG8_SA(1, 0), a3, voffA);
            PG8_WAIT_V(8); PG8_WAIT_L(0); PG8_BAR; PG8_MMA(1, 0, At, B0); PG8_MMA(1, 1, At, B1); PG8_BAR; PG8_SCHED;
            } else {
            PG8_LDB(B0, 0, 0); PG8_SCHED; PG8_LDA(At, 0, 0); PG8_STAGE(PG8_SA(1, 1), a1 + hstep, voffA);
            PG8_WAIT_L(8); PG8_BAR; PG8_WAIT_L(0); PG8_MMA(0, 0, At, B0); PG8_BAR; PG8_SCHED;
            PG8_LDB(B1, 0, 1); PG8_STAGE(PG8_SB(0, 0), b2, voffB);
            PG8_BAR; PG8_WAIT_L(0); PG8_MMA(0, 1, At, B1); PG8_BAR;
            PG8_LDA(At, 0, 1); PG8_STAGE(PG8_SA(0, 0), a2, voffA);
            PG8_BAR; PG8_WAIT_L(0); PG8_MMA(1, 0, At, B0); PG8_BAR; PG8_SCHED;
            PG8_STAGE(PG8_SB(0, 1), b2 + hstep, voffB);
            PG8_WAIT_V(6); PG8_BAR; PG8_MMA(1, 1, At, B1); PG8_BAR;
            PG8_LDB(B0, 1, 0); PG8_SCHED; PG8_LDA(At, 1, 0); PG8_STAGE(PG8_SA(0, 1), a2 + hstep, voffA);
            PG8_WAIT_L(8); PG8_BAR; PG8_WAIT_L(0); PG8_MMA(0, 0, At, B0); PG8_BAR; PG8_SCHED;
            PG8_LDB(B1, 1, 1); PG8_STAGE(PG8_SB(1, 0), b3, voffB);
            PG8_BAR; PG8_WAIT_L(0); PG8_MMA(0, 1, At, B1); PG8_BAR;
            PG8_LDA(At, 1, 1); PG8_STAGE(PG8_SA(1, 0), a3, voffA);
            PG8_BAR; PG8_WAIT_L(0); PG8_MMA(1, 0, At, B0); PG8_BAR; PG8_SCHED;
            PG8_STAGE(PG8_SB(1, 1), b3 + hstep, voffB);
            PG8_WAIT_V(6); PG8_BAR; PG8_MMA(1, 1, At, B1); PG8_BAR;
            }
        }
        if constexpr (ALIGN_EPI) { if (wr == 0) PG8_BAR; }
        if constexpr (!Epi::AFTER_DRAIN) { E(acc, cur, wr, wc, fr, fq, lds + STAGE_BYTES); S.done(cur); }
        if (!has_next) break;
#pragma unroll
        for (int a = 0; a < 2; ++a)
#pragma unroll
            for (int b = 0; b < 2; ++b)
#pragma unroll
                for (int m = 0; m < 4; ++m)
#pragma unroll
                    for (int n = 0; n < 2; ++n) acc[a][b][m][n] = (f32x4){0.f, 0.f, 0.f, 0.f};
        cur = nxt; cA = nA; cB = nB; ++ui;
        if constexpr (ALIGN_EPI) { if (wr == 1) PG8_BAR; }
    }
    PG8_WAIT_V(0);
    if constexpr (!ALIGN_EPI) { if (wr == 0) PG8_BAR; }
    PG8_BAR;
    if constexpr (Epi::AFTER_DRAIN) { E.fused(acc, cur, wr, wc, fr, fq, lds, wid, lane); S.done(cur); }
#undef PG8_SA
#undef PG8_SB
#undef PG8_STAGE
#undef PG8_LDA
#undef PG8_LDB
#undef PG8_MMA
#undef PG8_WAIT_V
#undef PG8_WAIT_L
#undef PG8_BAR
#undef PG8_SCHED
}
}
#define GAS __attribute__((address_space(1)))
#define LAS __attribute__((address_space(3)))
typedef unsigned short bf16;
typedef unsigned v4u __attribute__((ext_vector_type(4)));
typedef float f32x4 __attribute__((ext_vector_type(4)));
typedef short bf16x8 __attribute__((ext_vector_type(8)));
typedef GAS unsigned gu32;
typedef GAS unsigned long long gu64;
#define RLX_AGENT __ATOMIC_RELAXED, __HIP_MEMORY_SCOPE_AGENT
#define LDS_WAIT() asm volatile("s_waitcnt lgkmcnt(0)" ::: "memory")
#define VM_WAIT() asm volatile("s_waitcnt vmcnt(0)" ::: "memory")
__device__ __forceinline__ unsigned long long rt() { return __builtin_amdgcn_s_memrealtime(); }
__device__ __forceinline__ unsigned f2bf(float f) { unsigned u = __builtin_bit_cast(unsigned, f); return (u + 0x7fffu + ((u >> 16) & 1u)) >> 16; }
__device__ __forceinline__ unsigned pk2(float lo, float hi) { return f2bf(lo) | (f2bf(hi) << 16); }

#define XB_TMO      128
#define XB_XCNT(j)  (256  + 64 * (j))
#define XB_XSUB(j)  (1280 + 64 * (j))
#define XB_XGEN(j)  (2304 + 64 * (j))
#define XB_TOP      3328
#define XB_TOPGEN   3392
#define XCD_BAR_WORDS 3456
#define XB_SPIN_CAP (1u << 18)

__device__ __forceinline__ unsigned xb_ld(unsigned* p)              { return __hip_atomic_load(p, __ATOMIC_RELAXED, __HIP_MEMORY_SCOPE_AGENT); }
__device__ __forceinline__ unsigned xb_add(unsigned* p, unsigned v) { return __hip_atomic_fetch_add(p, v, __ATOMIC_RELAXED, __HIP_MEMORY_SCOPE_AGENT); }
__device__ __forceinline__ unsigned xb_xcc_id() { return (unsigned)__builtin_amdgcn_s_getreg((3 << 11) | 20) & 0xFu; }
#define XB_SPIN(cond, bar) do { unsigned _sp = 0; while (cond) { __builtin_amdgcn_s_sleep(1); \
    if ((++_sp & 255u) == 0u) { if (xb_ld(&(bar)[XB_TMO])) break; if (_sp > XB_SPIN_CAP) { atomicAdd(&(bar)[XB_TMO], 1u); break; } } } } while (0)

struct XcdBarrier {
    unsigned* bar; unsigned x;
    volatile LAS unsigned* st;
};

__device__ __forceinline__ XcdBarrier xcd_barrier_post(unsigned* bar, volatile LAS unsigned* st) {
    XcdBarrier b; b.bar = bar; b.x = xb_xcc_id(); b.st = st;
    if (threadIdx.x == 0) (void)xb_add(&bar[XB_XCNT(b.x)], 1u);
    return b;
}
__device__ __forceinline__ void xcd_barrier_complete(unsigned* bar, unsigned x, unsigned& nloc, unsigned& nx) {
    const unsigned G = gridDim.x * gridDim.y * gridDim.z;
    unsigned sum, cnt, mine, sp = 0u;
    for (;;) {
        sum = 0u; cnt = 0u; mine = 0u;
#pragma unroll
        for (unsigned j = 0; j < 16; ++j) { const unsigned c = xb_ld(&bar[XB_XCNT(j)]); sum += c; cnt += (c > 0u) ? 1u : 0u; mine = (j == x) ? c : mine; }
        if (sum == G) break;
        __builtin_amdgcn_s_sleep(1);
        if ((++sp & 255u) == 0u) { if (xb_ld(&bar[XB_TMO])) break; if (sp > XB_SPIN_CAP) { atomicAdd(&bar[XB_TMO], 1u); break; } }
    }
    nloc = mine > 0u ? mine : 1u; nx = cnt > 0u ? cnt : 1u;
}

__device__ __forceinline__ void xcd_barrier(const XcdBarrier& b) {
    asm volatile("s_waitcnt vmcnt(0)" ::: "memory");
    __syncthreads();
    if (threadIdx.x == 0) {
        unsigned* bar = b.bar;
        __builtin_amdgcn_s_waitcnt(0);
        unsigned nloc = b.st[0], nx = b.st[1];
        if (nloc == 0u) { xcd_barrier_complete(bar, b.x, nloc, nx); b.st[0] = nloc; b.st[1] = nx; }
        const unsigned old = xb_add(&bar[XB_XSUB(b.x)], 1u);
        const unsigned gen = old / nloc;
        if (old + 1u == (gen + 1u) * nloc) {
            __builtin_amdgcn_fence(__ATOMIC_RELEASE, "agent");
            asm volatile("s_waitcnt vmcnt(0)" ::: "memory");
            const unsigned og = xb_add(&bar[XB_TOP], 1u);
            const unsigned tg = og / nx;
            if (og + 1u == (tg + 1u) * nx) xb_add(&bar[XB_TOPGEN], 1u);
            else XB_SPIN(xb_ld(&bar[XB_TOPGEN]) == tg, bar);
            __builtin_amdgcn_fence(__ATOMIC_ACQUIRE, "agent");
            xb_add(&bar[XB_XGEN(b.x)], 1u);
            asm volatile("s_waitcnt vmcnt(0)" ::: "memory");
        } else {
            XB_SPIN(xb_ld(&bar[XB_XGEN(b.x)]) == gen, bar);
            __builtin_amdgcn_fence(__ATOMIC_ACQUIRE, "agent");
            asm volatile("s_waitcnt vmcnt(0)" ::: "memory");
        }
    }
    __syncthreads();
}

constexpr int NWAVES = 8;
constexpr int D = 1024, NB = 32, SEQ = 2048, DB = 16, DSEQ = 64, NMETA = 16;
constexpr int HEADS = 4, DKH = 128, DVH = 256, RANK = 16, PW = 512, PG = 128, PBUF = 15, DFF = 2816;
constexpr int MP = NB * SEQ;
constexpr int MS = DB * DSEQ;
constexpr int MO = MP + MS;
constexpr int ROW_META = MO;
constexpr int MIN_ROWS = MO + 256;
constexpr int NPROJ = 4608;
constexpr int C_Q = 0, C_K = 512, C_V = 1024, C_P = 2048, C_GA = 2560, C_GB = 3584;
constexpr int NIN = 5632;
constexpr int NIN_ALLOC = 5888;
constexpr int NGU = 2 * DFF;
constexpr int D_IN = 5648;
constexpr size_t OFF_YP = 0, OFF_YS = (size_t)MP * D, OFF_SGP = OFF_YS + (size_t)MS * D, OFF_SPP = OFF_SGP + (size_t)NB * HEADS * DKH * DVH,
                 OFF_SGS = OFF_SPP + (size_t)NB * PBUF * PW, OFF_SPS = OFF_SGS + (size_t)DB * HEADS * DKH * DVH;
constexpr size_t MiB = 1u << 20;
constexpr size_t WS_CTL = 0, CTL_ZERO_BYTES = 1 * MiB;
constexpr size_t WS_WIN = 1 * MiB;
constexpr size_t WS_WOUT = 13 * MiB;
constexpr size_t WS_WGU = 15 * MiB;
constexpr size_t WS_WDN = 26 * MiB;
constexpr size_t WS_ALR = 32 * MiB;
constexpr size_t WS_WPT = 36 * MiB + 512 * 1024;
constexpr size_t WS_EXPBL = 37 * MiB;
constexpr size_t WS_SS2 = 40 * MiB;
constexpr size_t WS_SS3 = 44 * MiB + 512 * 1024;
constexpr size_t WS_XN = 50 * MiB;
constexpr size_t WS_MERGED = WS_XN;
constexpr size_t WS_PROJ = 182 * MiB;
constexpr size_t WS_ACT = WS_PROJ;
constexpr size_t WS_HB = WS_PROJ + 360 * MiB;
constexpr size_t WS_PH = WS_PROJ + (size_t)MIN_ROWS * NPROJ * 2;
constexpr size_t WS_HBS = WS_PH + 256 * 1024;
constexpr size_t WS_ACTS = WS_HBS + 2 * MiB;
constexpr size_t WS_PART = WS_ACTS + 6 * MiB;
constexpr size_t WS_END = WS_PART + 16 * MiB;
static_assert(WS_WIN + (size_t)NIN_ALLOC * D * 2 <= WS_WOUT && WS_WGU + (size_t)NGU * D * 2 <= WS_WDN && WS_WDN + (size_t)D * DFF * 2 <= WS_ALR, "ws map (weights)");
static_assert(WS_ALR + (size_t)MIN_ROWS * 64 <= WS_WPT && WS_WPT + 4 * 256 * 128 * 2 <= WS_EXPBL && WS_EXPBL + (size_t)4288 * 512 <= WS_SS2 && WS_SS2 + (size_t)MO * 64 <= WS_SS3 && WS_SS3 + (size_t)MO * 64 <= WS_XN, "ws map (small)");
static_assert(WS_XN + (size_t)MIN_ROWS * D * 2 <= WS_PROJ && WS_ACT + (size_t)MO * DFF * 2 <= WS_HB && WS_HB + (size_t)MO * D * 2 <= WS_PH, "ws map (big)");
constexpr int N_HELP = 128;
constexpr int CW_TMO = 0, CW_CODE = 1, CW_BAR = 4096, CW_HBAR = 8192, CW_LATE = 8192 + 64 * 8, CW_WTICKET = CW_LATE + 64;
constexpr int RING_OFF = 0, RING_BYTES = 131072;
constexpr int LDS_BYTES = 155648;
constexpr int LDSCTL_OFF = LDS_BYTES - 512, MISC_OFF = LDSCTL_OFF + 320;
constexpr int TAB_OFF = RING_OFF + RING_BYTES;
static_assert(TAB_OFF + 8 * 1024 + 64 <= LDSCTL_OFF, "epilogue tables");

struct Frame {
    LAS unsigned char* lds;
    volatile LAS unsigned* MISC;
    gu32* ctl;
    int tid, lane, wave, vcu, G;
};
__device__ __forceinline__ float wave_sum(float v) {
#pragma unroll
    for (int o = 1; o < 64; o <<= 1) v += __shfl_xor(v, o);
    return v;
}
__device__ __forceinline__ float bf2f(unsigned short u) { return __builtin_bit_cast(float, (unsigned)u << 16); }
__device__ __forceinline__ float bflo(unsigned u) { return __builtin_bit_cast(float, u << 16); }
__device__ __forceinline__ float bfhi(unsigned u) { return __builtin_bit_cast(float, u & 0xffff0000u); }

__device__ __forceinline__ void p0_transpose_item(const float* W, int ldw, int k0, int n0, int ncols, bf16* WT, int ldt, int dst_row0, const float* ksc, float sc, LAS float* scr, int lane, const bool vperm = false) {
#pragma unroll 8
    for (int i = 0; i < 32; ++i) { const int kk = 2 * i + (lane >> 5), n = lane & 31;
        float v = (n < ncols) ? W[(size_t)(k0 + kk) * ldw + n0 + n] : 0.f;
        v *= (ksc ? ksc[k0 + kk] : 1.0f) * sc;
        scr[kk * 33 + n] = v; }
    LDS_WAIT(); asm volatile("" ::: "memory");
    const int c = lane & 7;
#pragma unroll
    for (int j = 0; j < 4; ++j) { const int n = (lane >> 3) + 8 * j; const LAS float* s = scr + (8 * c) * 33 + n;
        v4u o; o.x = pk2(s[0 * 33], s[1 * 33]); o.y = pk2(s[2 * 33], s[3 * 33]); o.z = pk2(s[4 * 33], s[5 * 33]); o.w = pk2(s[6 * 33], s[7 * 33]);
        const int nd = vperm ? (((n >> 2) & 1) * 16 + (n >> 3) * 4 + (n & 3)) : n;
        if (n < ncols) *(GAS v4u*)(WT + (size_t)(dst_row0 + nd) * ldt + k0 + 8 * c) = o; }
    LDS_WAIT(); asm volatile("" ::: "memory");
}
__device__ __forceinline__ void rms_row_to_bf16(const float* xrow, const float* gain, bf16* orow, int lane) {
    const GAS f32x4* xr = (const GAS f32x4*)xrow + lane; const GAS f32x4* gr = (const GAS f32x4*)gain + lane;
    f32x4 v[4]; float s = 0.f;
#pragma unroll
    for (int j = 0; j < 4; ++j) { v[j] = xr[64 * j]; s += (v[j].x * v[j].x + v[j].y * v[j].y) + (v[j].z * v[j].z + v[j].w * v[j].w); }
    const float rstd = 1.0f / sqrtf(wave_sum(s) * (1.f / D) + 1e-6f);
    GAS unsigned long long* o8 = (GAS unsigned long long*)orow + lane;
#pragma unroll
    for (int j = 0; j < 4; ++j) { const f32x4 g = gr[64 * j];
        o8[64 * j] = (unsigned long long)pk2(v[j].x * rstd * g.x, v[j].y * rstd * g.y) | ((unsigned long long)pk2(v[j].z * rstd * g.z, v[j].w * rstd * g.w) << 32); }
}

struct Args { const float* in[18]; float* out; unsigned char* ws; };
typedef const __attribute__((address_space(4))) char* kargp_t;
__device__ __forceinline__ const void* karg(unsigned idx) {
    unsigned off = idx * 8u; asm volatile("" : "+s"(off));
    kargp_t kp = (kargp_t)__builtin_amdgcn_kernarg_segment_ptr();
    return *(const void* const __attribute__((address_space(4)))*)(kp + off);
}
#define KIN(i) ((const float*)karg(i))
#define KOUT() ((float*)karg(18))
#define KWS() ((unsigned char*)karg(19))


namespace wi {
constexpr int KB = D / 64;
constexpr int I_IN = KB * 176;
constexpr int I_WP = 4 * 2 * 8;
constexpr int I_OUT = KB * (D / 32);
constexpr int I_G = KB * (DFF / 32), I_U = I_G;
constexpr int I_DN = (DFF / 64) * (D / 32);
constexpr int N_EARLY = I_IN + I_WP;
constexpr int N_LATE = I_OUT + I_G + I_U + I_DN;
}
__device__ __forceinline__ void p0_weight_item(Frame& F, int r, LAS float* scr) {
    using namespace wi;
    unsigned char* ws = KWS();
    const float qsc = 0.08838834764831845f;
    if (r < I_IN) { const float* w_in = KIN(6); bf16* WIN = (bf16*)(ws + WS_WIN);
        const int kb = r / 176, nbk = r % 176; int src, dst, nc = 32; float sc = 1.0f;
        if (nbk < 64) { src = 32 * nbk; dst = 32 * nbk; if (nbk < 16) sc = qsc; }
        else if (nbk < 80) { const int i = nbk - 64; src = 3088 + 32 * i; dst = 2048 + 32 * i; }
        else if (nbk < 144) { const int i = nbk - 80, j = i >> 3, hf = (i >> 2) & 1, sub = i & 3; src = (hf ? 3600 : 2048) + 128 * j + 32 * sub; dst = 2560 + 256 * j + 128 * hf + 32 * sub; }
        else { const int i = nbk - 144; src = 4624 + 32 * i; dst = 4608 + 32 * i; }
        p0_transpose_item(w_in, D_IN, 64 * kb, src, nc, WIN, D, dst, nullptr, sc, scr, F.lane, nbk >= 32 && nbk < 64); return; } r -= I_IN;
    if (r < I_WP) { const float* w_pool = KIN(10); const int gi = r >> 4, kb = (r >> 3) & 1, nb = r & 7;
        p0_transpose_item(w_pool + (size_t)gi * PG * DVH, DVH, 64 * kb, 32 * nb, 32, (bf16*)(ws + WS_WPT), PG, gi * DVH + 32 * nb, nullptr, 1.0f, scr, F.lane); return; } r -= I_WP;
    if (r < I_OUT) { const int kb = r / 32, nb = r % 32; p0_transpose_item(KIN(12), D, 64 * kb, 32 * nb, 32, (bf16*)(ws + WS_WOUT), D, 32 * nb, nullptr, 1.0f, scr, F.lane); return; } r -= I_OUT;
    if (r < I_G) { const int kb = r / 88, nb = r % 88; p0_transpose_item(KIN(14), DFF, 64 * kb, 32 * nb, 32, (bf16*)(ws + WS_WGU), D, (nb >> 2) * 256 + (nb & 3) * 32, KIN(13), 1.0f, scr, F.lane); return; } r -= I_G;
    if (r < I_U) { const int kb = r / 88, nb = r % 88; p0_transpose_item(KIN(15), DFF, 64 * kb, 32 * nb, 32, (bf16*)(ws + WS_WGU), D, (nb >> 2) * 256 + 128 + (nb & 3) * 32, KIN(13), 1.0f, scr, F.lane); return; } r -= I_U;
    { const int kb = r / 32, nb = r % 32; p0_transpose_item(KIN(16), D, 64 * kb, 32 * nb, 32, (bf16*)(ws + WS_WDN), DFF, 32 * nb, nullptr, 1.0f, scr, F.lane); }
}
__device__ __forceinline__ void late_weight_items(Frame& F, const int e, const int ne) {
    LAS float* scr = (LAS float*)(F.lds + RING_OFF + F.wave * 16384);
    for (int t = e * NWAVES + F.wave; t < wi::N_LATE; t += ne * NWAVES) p0_weight_item(F, wi::N_EARLY + t, scr);
}
__device__ __forceinline__ void p0_prologue(Frame& F) {
    unsigned char* ws = KWS();
    LAS float* scr = (LAS float*)(F.lds + RING_OFF + F.wave * 16384);
    const int gw = F.vcu * NWAVES + F.wave, NGW = F.G * NWAVES;
    bf16* WIN = (bf16*)(ws + WS_WIN);
    for (int it = gw; it < wi::N_EARLY; it += NGW) p0_weight_item(F, it, scr);
    { GAS v4u* z = (GAS v4u*)(WIN + (size_t)(5632 + 16) * D); const int n16 = 240 * 2048 / 16; const v4u zero = {0u, 0u, 0u, 0u};
      for (int i = gw * 64 + F.lane; i < n16; i += NGW * 64) z[i] = zero; }
    { const float* sp = KIN(3); bf16* PH = (bf16*)(ws + WS_PH); for (int i = gw * 64 + F.lane; i < DB * PBUF * PW; i += NGW * 64) PH[i] = (bf16)f2bf(sp[i]); }
    bf16* XN = (bf16*)(ws + WS_XN); const float* g1 = KIN(5); const float* xpr = KIN(0); const float* xsm = KIN(1); const float* xmt = KIN(4);
    float* ALRO = (float*)(ws + WS_ALR);
    constexpr int LP = 2064;
    LAS unsigned char* Wt = F.lds + RING_OFF;
    LAS unsigned char* At = F.lds + RING_OFF + 16 * LP + 256 + F.wave * (4 * LP + 192);
    __syncthreads();
    { const float* w_in = KIN(6); const int k0 = 2 * F.tid; const float* w0 = w_in + (size_t)k0 * D_IN + 3072;
#pragma unroll
      for (int q = 0; q < 4; ++q) { const f32x4 a = *(const f32x4*)(w0 + 4 * q), b = *(const f32x4*)(w0 + D_IN + 4 * q);
#pragma unroll
          for (int i = 0; i < 4; ++i) *(LAS unsigned*)(Wt + (4 * q + i) * LP + 2 * k0) = pk2(a[i], b[i]); } }
    __syncthreads();
    int lz = F.lane; asm volatile("" : "+v"(lz));
    const unsigned l15 = lz & 15, kq = lz >> 4;
    const LAS unsigned char* wrd = Wt + l15 * LP + 16 * kq;
    const LAS unsigned char* ard = At + (l15 & 3) * LP + 16 * kq;
    LAS unsigned char* awr = At + 8 * lz;
    const GAS f32x4* gr = (const GAS f32x4*)g1 + F.lane;
    f32x4 gv[4];
#pragma unroll
    for (int j = 0; j < 4; ++j) gv[j] = gr[64 * j];
#define P0_ROWPTR(m) (((m) < MP) ? xpr + (size_t)(m) * D : ((m) < MO) ? xsm + (size_t)((m) - MP) * D : xmt + (size_t)(((m) < MO + NMETA ? (m) : MO) - MO) * D)
    f32x4 vn[4][4];
    { const int m0 = 4 * gw;
      if (m0 < MIN_ROWS) {
#pragma unroll
        for (int r = 0; r < 4; ++r) { const GAS f32x4* xr = (const GAS f32x4*)P0_ROWPTR(m0 + r) + F.lane;
#pragma unroll
            for (int j = 0; j < 4; ++j) vn[r][j] = __builtin_nontemporal_load(&xr[64 * j]); } } }
    for (int m0 = 4 * gw; m0 < MIN_ROWS; m0 += 4 * NGW) {
        f32x4 v[4][4];
#pragma unroll
        for (int r = 0; r < 4; ++r)
#pragma unroll
            for (int j = 0; j < 4; ++j) v[r][j] = vn[r][j];
        { const int mn = (m0 + 4 * NGW < MIN_ROWS) ? m0 + 4 * NGW : m0;
#pragma unroll
          for (int r = 0; r < 4; ++r) { const GAS f32x4* xr = (const GAS f32x4*)P0_ROWPTR(mn + r) + F.lane;
#pragma unroll
              for (int j = 0; j < 4; ++j) vn[r][j] = __builtin_nontemporal_load(&xr[64 * j]); } }
#pragma unroll
        for (int r = 0; r < 4; ++r) { const int m = m0 + r; float s = 0.f;
#pragma unroll
            for (int j = 0; j < 4; ++j) s += (v[r][j].x * v[r][j].x + v[r][j].y * v[r][j].y) + (v[r][j].z * v[r][j].z + v[r][j].w * v[r][j].w);
            const float rstd = (m < MO + NMETA) ? 1.0f / sqrtf(wave_sum(s) * (1.f / D) + 1e-6f) : 0.f;
            GAS unsigned long long* o8 = (GAS unsigned long long*)(XN + (size_t)m * D) + F.lane;
#pragma unroll
            for (int j = 0; j < 4; ++j) { const f32x4 g = gv[j];
                const unsigned long long w_ = (unsigned long long)pk2(v[r][j].x * rstd * g.x, v[r][j].y * rstd * g.y) | ((unsigned long long)pk2(v[r][j].z * rstd * g.z, v[r][j].w * rstd * g.w) << 32);
                o8[64 * j] = w_; *(LAS unsigned long long*)(awr + r * LP + 512 * j) = w_; } }
        asm volatile("s_waitcnt lgkmcnt(0)" ::: "memory");
        f32x4 acc0 = {0.f, 0.f, 0.f, 0.f}, acc1 = acc0;
#pragma unroll
        for (int ks = 0; ks < 32; ks += 2) {
            acc0 = __builtin_amdgcn_mfma_f32_16x16x32_bf16(*(const LAS bf16x8*)(ard + 64 * ks), *(const LAS bf16x8*)(wrd + 64 * ks), acc0, 0, 0, 0);
            acc1 = __builtin_amdgcn_mfma_f32_16x16x32_bf16(*(const LAS bf16x8*)(ard + 64 * ks + 64), *(const LAS bf16x8*)(wrd + 64 * ks + 64), acc1, 0, 0, 0); }
        const f32x4 acc = acc0 + acc1;
        if (kq == 0) {
#pragma unroll
            for (int e = 0; e < 4; ++e) ALRO[(size_t)(m0 + e) * 16 + l15] = acc[e]; }
        asm volatile("s_waitcnt lgkmcnt(0)" ::: "memory");
    }
#undef P0_ROWPTR
    __syncthreads();
}


typedef short s16x4 __attribute__((ext_vector_type(4)));
typedef unsigned u32x2 __attribute__((ext_vector_type(2)));
typedef float f32x2g __attribute__((ext_vector_type(2)));
typedef __bf16 bf16x2n __attribute__((ext_vector_type(2)));
__device__ __forceinline__ unsigned pkbf(float a, float b) { f32x2g v = {a, b}; bf16x2n r = __builtin_convertvector(v, bf16x2n); return __builtin_bit_cast(unsigned, r); }
__device__ __forceinline__ unsigned off_b(unsigned row, unsigned ch) { return 256u * row + 16u * (ch ^ (((row & 3u) << 2) | ((row >> 2) & 3u))); }
#define MFMA16(a, b, c) __builtin_amdgcn_mfma_f32_16x16x32_bf16((a), (b), (c), 0, 0, 0)
__device__ __forceinline__ bf16x8 tr_frag(LAS unsigned char* img, unsigned lane, unsigned c, unsigned ks) {
    const unsigned g = lane >> 4, q = (lane & 15) >> 2, p = lane & 3;
    const unsigned a0 = off_b(32 * ks + 8 * g + q, 2 * c + (p >> 1)) + 8 * (p & 1), a1 = off_b(32 * ks + 8 * g + 4 + q, 2 * c + (p >> 1)) + 8 * (p & 1);
    const s16x4 lo = __builtin_amdgcn_ds_read_tr16_b64_v4i16((LAS s16x4*)(img + a0)), hi = __builtin_amdgcn_ds_read_tr16_b64_v4i16((LAS s16x4*)(img + a1));
    return __builtin_shufflevector(lo, hi, 0, 1, 2, 3, 4, 5, 6, 7);
}
__device__ __forceinline__ bf16x8 row_frag(LAS unsigned char* img, unsigned lane, unsigned rb, unsigned ks) { return *(const LAS bf16x8*)(img + off_b((lane & 15) + 16 * rb, 4 * ks + (lane >> 4))); }

constexpr int N_ITEMS_P = NB * HEADS * 33, N_ITEMS = N_ITEMS_P + DB * HEADS;
#define GLA_CBASE(prm, b, cc) ((prm) ? ((cc) == 0 ? ROW_META - 48 : (b) * SEQ + ((cc) - 1) * 64) : (MP + (b) * DSEQ))

constexpr int QK_STAGE = 32768;
constexpr int QK_ALR = 0;
typedef float f32x2q __attribute__((ext_vector_type(2)));
__device__ __forceinline__ f32x2q logsig16_pk(f32x2q x) {
    f32x2q r;
#pragma unroll
    for (int e = 0; e < 2; ++e) { const float xc = __builtin_amdgcn_fmed3f(x[e], -80.0f, 80.0f); r[e] = __builtin_amdgcn_logf(1.0f + __builtin_amdgcn_exp2f(xc * -1.44269504089f)) * (-0.69314718056f / 16.0f); }
    return r;
}
template <int TMIN>
__device__ __forceinline__ void gla_qk_item(bf16* PROJ, const float* ALRF, float* EXPBL, const float* w2, const float* b_alpha, LAS unsigned char* La, LAS unsigned char* Ls, const unsigned lane, const int item, const int cbase, const int h) {
    { const float* ap = ALRF + (size_t)cbase * 16;
#pragma unroll
      for (int q = 0; q < 4; ++q) { const unsigned i = lane + 64u * q; const f32x4 v = ((int)(i >> 2) >= TMIN) ? *(const f32x4*)(ap + 4u * i) : (f32x4){0.f, 0.f, 0.f, 0.f}; *(LAS f32x4*)(La + 16u * i) = v; } }
    f32x2q w2r[16];
#pragma unroll
    for (int j = 0; j < 16; ++j) w2r[j] = *(const f32x2q*)(w2 + j * 512 + h * DKH + 2 * lane);
    const f32x2q bias = *(const f32x2q*)(b_alpha + h * DKH + 2 * lane);
    asm volatile("s_waitcnt lgkmcnt(0)" ::: "memory");
    f32x2q bsum = {0.f, 0.f};
    LAS unsigned char* Lq = Ls, *Lk = Ls + 4096;
    const unsigned srow = lane >> 4, sch = lane & 15u;
    const bf16* qg = PROJ + (size_t)cbase * NPROJ + C_Q + h * DKH + 8u * sch; const bf16* kg = PROJ + (size_t)cbase * NPROJ + C_K + h * DKH + 8u * sch;
    v4u nq[4], nk[4];
#define QK_FETCH(qr) do { _Pragma("unroll") for (int i = 0; i < 4; ++i) { const unsigned t = 16u * (qr) + 4u * i + srow; nq[i] = *(const v4u*)(qg + t * NPROJ); nk[i] = *(const v4u*)(kg + t * NPROJ); } } while (0)
    constexpr int Q0 = TMIN / 16;
    QK_FETCH(Q0);
#pragma unroll 1
    for (int qr = Q0; qr < 4; ++qr) {
#pragma unroll
        for (int i = 0; i < 4; ++i) { *(LAS v4u*)(Lq + (4u * i + srow) * 256u + 16u * sch) = nq[i]; *(LAS v4u*)(Lk + (4u * i + srow) * 256u + 16u * sch) = nk[i]; }
        asm volatile("s_waitcnt lgkmcnt(0)" ::: "memory");
        { const int qn = (qr + 1 < 4) ? qr + 1 : qr; QK_FETCH(qn); }
#pragma unroll
        for (int r = 0; r < 16; ++r) { const int t = 16 * qr + r;
            const LAS f32x4* ar = (const LAS f32x4*)(La + t * 64); const f32x4 a0 = ar[0], a1 = ar[1], a2 = ar[2], a3 = ar[3];
            f32x2q x0 = bias, x1 = {0.f, 0.f};
#pragma unroll
            for (int j = 0; j < 4; ++j) { x0 += w2r[j] * a0[j]; x1 += w2r[4 + j] * a1[j]; x0 += w2r[8 + j] * a2[j]; x1 += w2r[12 + j] * a3[j]; }
            bsum += logsig16_pk(x0 + x1);
            const float e0 = pg8::fast_exp(bsum[0]), e1 = pg8::fast_exp(bsum[1]), n0 = pg8::fast_exp(-bsum[0]), n1 = pg8::fast_exp(-bsum[1]);
            LAS unsigned* qw = (LAS unsigned*)(Lq + r * 256 + 4u * lane); LAS unsigned* kw = (LAS unsigned*)(Lk + r * 256 + 4u * lane);
            const unsigned sq = *qw, sk = *kw;
            *qw = pkbf(bflo(sq) * e0, bfhi(sq) * e1); *kw = pkbf(bflo(sk) * n0, bfhi(sk) * n1); }
        asm volatile("s_waitcnt lgkmcnt(0)" ::: "memory");
#pragma unroll
        for (int i = 0; i < 4; ++i) { const unsigned t = 16u * qr + 4u * i + srow;
            *(v4u*)(const_cast<bf16*>(qg) + t * NPROJ) = *(const LAS v4u*)(Lq + (4u * i + srow) * 256u + 16u * sch); *(v4u*)(const_cast<bf16*>(kg) + t * NPROJ) = *(const LAS v4u*)(Lk + (4u * i + srow) * 256u + 16u * sch); }
        asm volatile("s_waitcnt lgkmcnt(0)" ::: "memory");
    }
#undef QK_FETCH
    *(f32x2q*)(EXPBL + (size_t)item * 128 + 2 * lane) = (f32x2q){pg8::fast_exp(bsum[0]), pg8::fast_exp(bsum[1])};
    asm volatile("s_waitcnt lgkmcnt(0)" ::: "memory");
}
__device__ __forceinline__ void gla_prep_qk(Frame& F, const int c_lo, const int c_hi, const bool with_sample, const int gw, const int NGW) {
    unsigned char* ws = KWS();
    bf16* PROJ = (bf16*)(ws + WS_PROJ); const float* ALRF = (const float*)(ws + WS_ALR); float* EXPBL = (float*)(ws + WS_EXPBL);
    const float* w2 = KIN(7); const float* b_alpha = KIN(8);
    int tid_ = F.tid; asm volatile("" : "+v"(tid_));
    const unsigned lane = (unsigned)tid_ & 63u;
    LAS unsigned char* La = F.lds + QK_ALR + F.wave * 4096;
    LAS unsigned char* Ls = F.lds + QK_STAGE + F.wave * 8192;
    const int nc = c_hi - c_lo, n_prompt = NB * HEADS * nc, total = n_prompt + (with_sample ? DB * HEADS : 0);
    for (int idx = gw; idx < total; idx += NGW) {
        const bool prm = idx < n_prompt;
        int b, h, c, item;
        if (prm) { const int bh = idx / nc; c = c_lo + (idx - bh * nc); b = bh >> 2; h = bh & 3; item = bh * 33 + c; } else { const int i = idx - n_prompt; b = i >> 2; h = i & 3; c = 0; item = N_ITEMS_P + i; }
        if (prm && c == 0 && b != 0) continue;
        const int cbase = GLA_CBASE(prm, b, c);
        if (prm && c == 0) gla_qk_item<48>(PROJ, ALRF, EXPBL, w2, b_alpha, La, Ls, lane, item, cbase, h);
        else gla_qk_item<0>(PROJ, ALRF, EXPBL, w2, b_alpha, La, Ls, lane, item, cbase, h);
    }
}

constexpr int PL_WP = 0;
constexpr int PL_MIX = 65536;
__device__ __forceinline__ void unpack8(const v4u w, f32x4& lo, f32x4& hi) { lo = (f32x4){bflo(w[0]), bfhi(w[0]), bflo(w[1]), bfhi(w[1])}; hi = (f32x4){bflo(w[2]), bfhi(w[2]), bflo(w[3]), bfhi(w[3])}; }
template <int WIN>
__device__ __forceinline__ void gla_pool_units(Frame& F, bf16* PROJ, float* outp, LAS unsigned char* L, const unsigned lane, const int h, const int t_lo, const int t_hi, const bool with_sample, const int hw, const int NHW) {
    constexpr float rwin = 1.0f / (float)WIN;
    constexpr unsigned PHOFF = (unsigned)MIN_ROWS * NPROJ;
    LAS unsigned char* Lm = L + PL_MIX + F.wave * 4096;
    const int nt = t_hi - t_lo, n_prompt = NB * nt, total = n_prompt + (with_sample ? DB * 4 : 0);
    for (int u = hw; u < total; u += NHW) {
        unsigned lz = lane; asm volatile("" : "+v"(lz));
        const bool prm = u < n_prompt; int b, tile;
        if (prm) { b = u / nt; tile = t_lo + (u - b * nt); } else { const int su = u - n_prompt; b = su >> 2; tile = su & 3; }
        const int t0 = 16 * tile;
        const unsigned row0 = prm ? b * SEQ : MP + b * DSEQ;
        const bool last = prm ? tile == 127 : tile == 3;
        {
            const int o = lz & 15, rq = lz >> 4; const int tb = t0 + 4 * rq;
            const unsigned curoff = row0 * NPROJ + C_P + h * PG + 8 * o;
            const unsigned negoff = prm ? (unsigned)(ROW_META + 16) * NPROJ + C_P + h * PG + 8 * o : PHOFF + (unsigned)(b * PBUF + PBUF) * PW + h * PG + 8 * o;
            const unsigned dneg = negoff - curoff; const int dpitch = prm ? 0 : PW - NPROJ;
#define POOL_ROW(tq) (*(const v4u*)(PROJ + (curoff + (unsigned)((tq) * NPROJ) + ((unsigned)((tq) >> 31) & (dneg + (unsigned)((tq) * dpitch))))))
            f32x4 s0 = {0.f, 0.f, 0.f, 0.f}, s1 = s0, c0[4], c1[4];
            v4u wn[4], wo[3];
#pragma unroll
            for (int i = 0; i < 4; ++i) wn[i] = POOL_ROW(tb + i);
#pragma unroll
            for (int i = 0; i < 3; ++i) wo[i] = POOL_ROW(tb + 1 + i - WIN);
#pragma unroll
            for (int j0 = 1; j0 < WIN; j0 += 8) { v4u pw[8];
#pragma unroll
                for (int jj = 0; jj < 8; ++jj) if (j0 + jj < WIN) pw[jj] = POOL_ROW(tb - (j0 + jj));
#pragma unroll
                for (int jj = 0; jj < 8; ++jj) if (j0 + jj < WIN) { f32x4 lo, hi; unpack8(pw[jj], lo, hi); s0 += lo; s1 += hi; } }
#pragma unroll
            for (int i = 0; i < 4; ++i) { unpack8(wn[i], c0[i], c1[i]); s0 += c0[i]; s1 += c1[i];
                if (i > 0) { f32x4 lo, hi; unpack8(wo[i - 1], lo, hi); s0 -= lo; s1 -= hi; }
                const f32x4 m0 = s0 * rwin - c0[i], m1 = s1 * rwin - c1[i];
                *(LAS v4u*)(Lm + off_b(4 * rq + i, o)) = (v4u){pkbf(m0[0], m0[1]), pkbf(m0[2], m0[3]), pkbf(m1[0], m1[1]), pkbf(m1[2], m1[3])};
                if (last && (4 * rq + i) >= 1) { float* po = outp + (prm ? OFF_SPP : OFF_SPS) + (size_t)(b * PBUF + (4 * rq + i - 1)) * PW + h * PG + 8 * o; *(f32x4*)po = c0[i]; *(f32x4*)(po + 4) = c1[i]; } }
#undef POOL_ROW
        }
        asm volatile("s_waitcnt lgkmcnt(0)" ::: "memory");
        const int l15 = lz & 15, g = lz >> 4;
        unsigned aks[4];
#pragma unroll
        for (int ks = 0; ks < 4; ++ks) aks[ks] = 256u * l15 + 16u * (g ^ ((l15 >> 2) & 3)) + 64u * (ks ^ (l15 & 3));
        bf16x8 mixf[4];
#pragma unroll
        for (int ks = 0; ks < 4; ++ks) mixf[ks] = *(const LAS bf16x8*)(Lm + aks[ks]);
        const unsigned gboff = (row0 + (unsigned)(t0 + l15)) * NPROJ + C_GB + h * DVH + 8 * g;
#pragma unroll
        for (int half = 0; half < 2; ++half) {
            v4u gbw[4];
#pragma unroll
            for (int dp = 0; dp < 4; ++dp) gbw[dp] = *(const v4u*)(PROJ + (gboff + 32u * (4 * half + dp)));
            f32x4 y[8];
#pragma unroll
            for (int d = 0; d < 8; ++d) { y[d] = (f32x4){0.f, 0.f, 0.f, 0.f};
#pragma unroll
                for (int ks = 0; ks < 4; ++ks) y[d] = MFMA16(*(const LAS bf16x8*)(L + PL_WP + aks[ks] + 4096 * (8 * half + d)), mixf[ks], y[d]); }
#pragma unroll
            for (int dp = 0; dp < 4; ++dp) { v4u ow;
#pragma unroll
                for (int hh = 0; hh < 2; ++hh) { const f32x4 yy = y[2 * dp + hh]; const unsigned w0 = gbw[dp][2 * hh], w1 = gbw[dp][2 * hh + 1];
                    ow[2 * hh] = pkbf(bflo(w0) * yy[0], bfhi(w0) * yy[1]); ow[2 * hh + 1] = pkbf(bflo(w1) * yy[2], bfhi(w1) * yy[3]); }
                *(v4u*)(PROJ + (gboff + 32u * (4 * half + dp))) = ow; }
            asm volatile("" ::: "memory");
        }
        asm volatile("s_waitcnt lgkmcnt(0)" ::: "memory");
    }
}
__device__ __forceinline__ void gla_prep_pool(Frame& F, const int t_lo, const int t_hi, const bool with_sample, const int hw, const int NHW) {
    unsigned char* ws = KWS(); float* outp = KOUT();
    bf16* PROJ = (bf16*)(ws + WS_PROJ); const bf16* WPT = (const bf16*)(ws + WS_WPT);
    LAS unsigned char* L = F.lds;
    int tid_ = F.tid; asm volatile("" : "+v"(tid_));
    const int tid = tid_; const unsigned lane = (unsigned)tid & 63u;
    const int h = F.vcu & 3;
    __syncthreads();
    { const bf16* wph = WPT + (size_t)h * DVH * PG;
#pragma unroll
      for (int q = 0; q < 8; ++q) { const unsigned i = (unsigned)tid + 512u * q, row = i >> 4, ch = i & 15u;
          const unsigned srow = 32u * (row >> 5) + 8u * ((row >> 2) & 3u) + 4u * ((row >> 4) & 1u) + (row & 3u);
          *(LAS v4u*)(L + PL_WP + off_b(row, ch)) = *(const v4u*)(wph + srow * PG + 8u * ch); } }
    __syncthreads();
    if (h == 0) gla_pool_units<2>(F, PROJ, outp, L, lane, h, t_lo, t_hi, with_sample, hw, NHW);
    else if (h == 1) gla_pool_units<4>(F, PROJ, outp, L, lane, h, t_lo, t_hi, with_sample, hw, NHW);
    else if (h == 2) gla_pool_units<8>(F, PROJ, outp, L, lane, h, t_lo, t_hi, with_sample, hw, NHW);
    else gla_pool_units<16>(F, PROJ, outp, L, lane, h, t_lo, t_hi, with_sample, hw, NHW);
    __syncthreads();
}

__device__ __forceinline__ void dma16(const void* gsrc, unsigned lds_dst) {
    unsigned keep;
    asm volatile("s_mov_b32 %0, m0\n\ts_mov_b32 m0, %2\n\ts_nop 0\n\tglobal_load_lds_dwordx4 %1, off\n\ts_mov_b32 m0, %0" : "=&s"(keep) : "v"(gsrc), "s"(lds_dst) : "memory");
}
constexpr int SC_BUF = 66560, SC_QT = 0, SC_KT = 16384, SC_V = 32768, SC_EX = 65536, SC_AT = 2 * SC_BUF, SC_RS = SC_AT + 9216, SC_END = SC_RS + 2 * 2048;
constexpr int AT_PITCH = 144;
static_assert(SC_END <= LDSCTL_OFF, "scan LDS map");
__device__ __forceinline__ void gla_scan(Frame& F, const int K0) {
    unsigned char* ws = KWS(); const float* st_gla = KIN(2); float* outp = KOUT();
    const bf16* ZPAGE = (const bf16*)(ws + WS_WIN) + (size_t)(5632 + 16) * D;
    const bf16* PROJ = (const bf16*)(ws + WS_PROJ); const float* EXPBL = (const float*)(ws + WS_EXPBL); bf16* MERGED = (bf16*)(ws + WS_MERGED);
    LAS unsigned char* L = F.lds; const unsigned lbase = (unsigned)(size_t)L;
    int tid_ = F.tid; asm volatile("" : "+v"(tid_));
    const int tid = tid_; const int w = F.wave;
    for (int u = F.vcu; u < 192; u += F.G) {
        const bool prm = u < 128; const int b = prm ? (u >> 2) : ((u - 128) >> 2), h = u & 3;
        int tu = tid; asm volatile("" : "+v"(tu));
        f32x4 S[8][2];
        { const unsigned l15u = tu & 15, gu = (tu >> 4) & 3; const float* s0h = st_gla + (size_t)(b * HEADS + h) * DKH * DVH + 32 * w;
#pragma unroll
          for (int kt = 0; kt < 8; ++kt)
#pragma unroll
            for (int dt = 0; dt < 2; ++dt) {
                if (prm) S[kt][dt] = (f32x4){0.f, 0.f, 0.f, 0.f};
                else { const unsigned o0 = (16u * kt + 4u * gu) * DVH + 8u * (l15u >> 2) + 4u * dt + (l15u & 3u); S[kt][dt] = (f32x4){s0h[o0], s0h[o0 + DVH], s0h[o0 + 2 * DVH], s0h[o0 + 3 * DVH]}; }
            } }
#define SCAN_ISSUE(cc, tm, tz, bf) do { const int cb_ = GLA_CBASE(prm, b, cc); const bf16* crow_ = PROJ + (size_t)cb_ * NPROJ + h * DVH; const bf16* crowk_ = PROJ + (size_t)cb_ * NPROJ + h * DKH; \
            const unsigned l_ = (unsigned)(tz) & 63u; const unsigned Lb_ = lbase + (unsigned)((bf) * SC_BUF); \
            _Pragma("unroll") for (int q = 0; q < 2; ++q) { const unsigned s = 4u * (q * 8u + w) + (l_ >> 4), ch = (l_ & 15u) ^ (((s & 3u) << 2) | ((s >> 2) & 3u)); const bool ok = (int)s >= (tm); \
                const bf16* srcq = ok ? crowk_ + (s * NPROJ + C_Q + 8u * ch) : ZPAGE + 8u * l_; const bf16* srck = ok ? crowk_ + (s * NPROJ + C_K + 8u * ch) : ZPAGE + 8u * l_; \
                dma16(srcq, Lb_ + SC_QT + (q * 8 + w) * 1024); dma16(srck, Lb_ + SC_KT + (q * 8 + w) * 1024); \
                _Pragma("unroll") for (int hf = 0; hf < 2; ++hf) { const bf16* srcv = ok ? crow_ + (s * NPROJ + C_V + hf * 128u + 8u * ch) : ZPAGE + 8u * l_; \
                    dma16(srcv, Lb_ + SC_V + hf * 16384 + (q * 8 + w) * 1024); } } \
            if (w == 0) { const int it_ = prm ? (((cc) == 0 ? 0 : b) * HEADS + h) * 33 + (cc) : N_ITEMS_P + b * HEADS + h; \
                dma16(EXPBL + (size_t)it_ * 128 + 4u * (l_ & 31u), Lb_ + SC_EX); } } while (0)
#pragma unroll
        for (int kt = 0; kt < 8; ++kt) asm volatile("" : "+v"(S[kt][0]), "+v"(S[kt][1]));
        __syncthreads();
        SCAN_ISSUE(0, (prm ? 48 : 0), tu, 0);
        asm volatile("s_waitcnt vmcnt(0)" ::: "memory");
        __syncthreads();
        const int nchunk = prm ? 33 : 1;
        for (int c2 = 0; c2 < nchunk; c2 += 2) {
#pragma unroll
          for (int par = 0; par < 2; ++par) {
            const int c = c2 + par; if (c >= nchunk) break;
            const int cbase = GLA_CBASE(prm, b, c);
            const bool emit = !(prm && c == 0);
            int tc = tid; asm volatile("" : "+v"(tc));
            const unsigned lane = (unsigned)tc & 63u; const int l15 = lane & 15, g = lane >> 4;
            const unsigned c2_ = ((unsigned)l15 >> 2) & 3u, l3_ = (unsigned)l15 & 3u, gh_ = (unsigned)g >> 1, g8_ = 8u * ((unsigned)g & 1u);
            const unsigned RB = 256u * l15 + 16u * ((unsigned)g ^ c2_);
            const unsigned Q0 = 256u * l15 + 16u * (gh_ ^ c2_) + g8_, Q1 = 256u * l15 + 16u * ((gh_ | 2u) ^ c2_) + g8_;
            unsigned xk[4];
#pragma unroll
            for (int ks = 0; ks < 4; ++ks) xk[ks] = 64u * ((unsigned)ks ^ l3_);
            const unsigned tq_ = (unsigned)l15 >> 2, tp_ = l3_;
            const unsigned s0_ = (tq_ << 2) | ((2u * g) & 3u), s1_ = (tq_ << 2) | ((2u * g + 1u) & 3u);
            const unsigned u0 = s0_ >> 1, u1 = s1_ >> 1;
            const unsigned T0 = 256u * (8u * g + tq_) + 8u * (tp_ & 1u) + 16u * ((tp_ >> 1) ^ (s0_ & 1u)), T1 = 256u * (8u * g + tq_ + 4u) + 8u * (tp_ & 1u) + 16u * ((tp_ >> 1) ^ (s1_ & 1u));
#define SC_ROWF(img, rb, ks) (*(const LAS bf16x8*)((img) + (RB + 4096u * (rb) + xk[ks])))
#define SC_TRF(img, cc, ks) __builtin_shufflevector(__builtin_amdgcn_ds_read_tr16_b64_v4i16((LAS s16x4*)((img) + (T0 + 8192u * (ks) + 32u * ((unsigned)(cc) ^ u0)))), \
                                                    __builtin_amdgcn_ds_read_tr16_b64_v4i16((LAS s16x4*)((img) + (T1 + 8192u * (ks) + 32u * ((unsigned)(cc) ^ u1)))), 0, 1, 2, 3, 4, 5, 6, 7)
            LAS unsigned char* Lb = L + par * SC_BUF;
            if (prm && K0 < 33 && c == K0 - 1) {
                if (tid == 0) { unsigned* cl = (unsigned*)(F.ctl + CW_LATE); unsigned sp = 0u;
                    while (__hip_atomic_load(cl, __ATOMIC_RELAXED, __HIP_MEMORY_SCOPE_AGENT) < (unsigned)N_HELP) { __builtin_amdgcn_s_sleep(4); if (++sp > (1u << 22)) break; }
                    __builtin_amdgcn_fence(__ATOMIC_ACQUIRE, "agent"); asm volatile("s_waitcnt vmcnt(0)" ::: "memory"); }
                asm volatile("s_waitcnt lgkmcnt(0)" ::: "memory"); __builtin_amdgcn_s_barrier(); asm volatile("" ::: "memory"); }
            v4u gA[4], gB[4];
            if (emit) { const bf16* crow = PROJ + (size_t)cbase * NPROJ + h * DVH;
#pragma unroll
                for (int tt = 0; tt < 4; ++tt)
                    { const unsigned po = (unsigned)(16 * tt + l15) * NPROJ + 32u * w + 8u * g;
                      asm volatile("global_load_dwordx4 %0, %1, off" : "=&v"(gA[tt]) : "v"(crow + (po + C_GA)) : "memory"); asm volatile("global_load_dwordx4 %0, %1, off" : "=&v"(gB[tt]) : "v"(crow + (po + C_GB)) : "memory"); } }
            { const int cn = (c + 1 < nchunk) ? c + 1 : c; SCAN_ISSUE(cn, 0, tc, (par ^ 1)); }
            {
                const int st = w & 3;
#pragma unroll
                for (int tq = 0; tq < 2; ++tq) { const int tt = 2 * (w >> 2) + tq; f32x4 acc = {0.f, 0.f, 0.f, 0.f};
#pragma unroll
                    for (int ks = 0; ks < 4; ++ks) acc = MFMA16(SC_ROWF(Lb + SC_KT, st, ks), SC_ROWF(Lb + SC_QT, tt, ks), acc);
                    const int tabs = 16 * tt + l15, sabs = 16 * st + 4 * g;
                    float m[4];
#pragma unroll
                    for (int e = 0; e < 4; ++e) m[e] = (sabs + e <= tabs) ? acc[e] : 0.f;
                    *(LAS u32x2*)(L + SC_AT + AT_PITCH * tabs + 2 * sabs) = (u32x2){pkbf(m[0], m[1]), pkbf(m[2], m[3])}; }
            }
            bf16x8 vf[2][2];
#pragma unroll
            for (int dt = 0; dt < 2; ++dt)
#pragma unroll
                for (int ks = 0; ks < 2; ++ks) vf[dt][ks] = SC_TRF(Lb + SC_V + (w >> 2) * 16384, 2 * (w & 3) + dt, ks);
            f32x4 o[2][4];
#pragma unroll
            for (int dt = 0; dt < 2; ++dt)
#pragma unroll
                for (int tt = 0; tt < 4; ++tt) o[dt][tt] = (f32x4){0.f, 0.f, 0.f, 0.f};
#pragma unroll
            for (int ks = 0; ks < 4; ++ks) {
                bf16x8 sa[2];
#pragma unroll
                for (int dt = 0; dt < 2; ++dt) { const f32x4 s0 = S[2 * ks][dt], s1 = S[2 * ks + 1][dt];
                    const v4u pk = {pkbf(s0[0], s0[1]), pkbf(s0[2], s0[3]), pkbf(s1[0], s1[1]), pkbf(s1[2], s1[3])}; sa[dt] = __builtin_bit_cast(bf16x8, pk); }
#pragma unroll
                for (int tt = 0; tt < 4; ++tt) { const unsigned t = 16 * tt + l15;
                    const u32x2 lo = *(const LAS u32x2*)(Lb + SC_QT + (Q0 + 4096u * tt + xk[ks])), hi = *(const LAS u32x2*)(Lb + SC_QT + (Q1 + 4096u * tt + xk[ks]));
                    const v4u bq4 = {lo[0], lo[1], hi[0], hi[1]}; const bf16x8 bq = __builtin_bit_cast(bf16x8, bq4);
#pragma unroll
                    for (int dt = 0; dt < 2; ++dt) o[dt][tt] = MFMA16(sa[dt], bq, o[dt][tt]); }
            }
#pragma unroll
            for (int kt = 0; kt < 8; ++kt) {
#pragma unroll
                for (int ks = 0; ks < 2; ++ks) { const bf16x8 ka = SC_TRF(Lb + SC_KT, kt, ks);
#pragma unroll
                    for (int dt = 0; dt < 2; ++dt) S[kt][dt] = MFMA16(ka, vf[dt][ks], S[kt][dt]); }
                const f32x4 e4 = *(const LAS f32x4*)(Lb + SC_EX + (16 * kt + 4 * g) * 4);
#pragma unroll
                for (int dt = 0; dt < 2; ++dt) S[kt][dt] = S[kt][dt] * e4; }
            asm volatile("s_waitcnt lgkmcnt(0)" ::: "memory"); __builtin_amdgcn_s_barrier(); asm volatile("" ::: "memory");
#pragma unroll
            for (int ks = 0; ks < 2; ++ks)
#pragma unroll
                for (int tt = 0; tt < 4; ++tt) { const bf16x8 ba = *(const LAS bf16x8*)(L + SC_AT + AT_PITCH * (16 * tt + l15) + 64 * ks + 16 * g);
#pragma unroll
                    for (int dt = 0; dt < 2; ++dt) o[dt][tt] = MFMA16(vf[dt][ks], ba, o[dt][tt]); }
#pragma unroll
            for (int tt = 0; tt < 4; ++tt) { float ss = pg8::dot4(o[0][tt]) + pg8::dot4(o[1][tt]); ss += __shfl_xor(ss, 16); ss += __shfl_xor(ss, 32);
                if (g == 0) ((LAS float*)(L + SC_RS + par * 2048))[(16 * tt + l15) * 8 + w] = ss; }
            asm volatile("s_waitcnt vmcnt(0) lgkmcnt(0)" ::: "memory"); __builtin_amdgcn_s_barrier(); asm volatile("" ::: "memory");
            if (emit) {
                bf16* mrow = MERGED + (size_t)cbase * D + h * DVH;
#pragma unroll
                for (int tt = 0; tt < 4; ++tt) asm volatile("" : "+v"(gA[tt]), "+v"(gB[tt]));
#pragma unroll
                for (int tt = 0; tt < 4; ++tt) { const int t = 16 * tt + l15;
                    const f32x4 r0 = *(const LAS f32x4*)(L + SC_RS + par * 2048 + t * 32), r1 = *(const LAS f32x4*)(L + SC_RS + par * 2048 + t * 32 + 16);
                    const float rstd = 1.0f / sqrtf((((r0[0] + r0[1]) + (r0[2] + r0[3])) + ((r1[0] + r1[1]) + (r1[2] + r1[3]))) * (1.0f / 256.0f) + 1e-6f);
                    v4u mw;
#pragma unroll
                    for (int dt = 0; dt < 2; ++dt) {
                        float mv[4];
#pragma unroll
                        for (int e = 0; e < 4; ++e) { const unsigned wa = gA[tt][2 * dt + (e >> 1)], wb_ = gB[tt][2 * dt + (e >> 1)];
                            const float ga = (e & 1) ? bfhi(wa) : bflo(wa), mb = (e & 1) ? bfhi(wb_) : bflo(wb_);
                            mv[e] = ga * (o[dt][tt][e] * rstd) + mb; }
                        mw[2 * dt] = pkbf(mv[0], mv[1]); mw[2 * dt + 1] = pkbf(mv[2], mv[3]); }
                    asm volatile("global_store_dwordx4 %0, %1, off\n\ts_nop 0" :: "v"(mrow + ((unsigned)t * D + 32u * w + 8u * g)), "v"(mw) : "memory"); }
            }
          }
        }
#undef SCAN_ISSUE
#undef SC_ROWF
#undef SC_TRF
        int to = tid; asm volatile("" : "+v"(to));
        { const unsigned l15u = to & 15, gu = (to >> 4) & 3; float* soh = outp + (prm ? OFF_SGP : OFF_SGS) + (size_t)(b * HEADS + h) * DKH * DVH + 32 * w;
#pragma unroll
          for (int kt = 0; kt < 8; ++kt)
#pragma unroll
            for (int dt = 0; dt < 2; ++dt) { const unsigned o0 = (16u * kt + 4u * gu) * DVH + 8u * (l15u >> 2) + 4u * dt + (l15u & 3u);
                soh[o0] = S[kt][dt][0]; soh[o0 + DVH] = S[kt][dt][1]; soh[o0 + 2 * DVH] = S[kt][dt][2]; soh[o0 + 3 * DVH] = S[kt][dt][3]; } }
    }
    __syncthreads();
}

__device__ __forceinline__ void final_norm_phase(Frame& F, const int row_lo, const int row_hi, const int gw, const int NGW, const bf16* h2base) {
    unsigned char* ws_ = KWS(); float* outp = KOUT();
    int ln = F.lane; asm volatile("" : "+v"(ln));
    const float* SS = (const float*)(ws_ + WS_SS3); const GAS f32x4* gr = (const GAS f32x4*)KIN(17) + 2 * ln;
    f32x4 g[2][2];
#pragma unroll
    for (int j = 0; j < 2; ++j) { g[j][0] = gr[128 * j]; g[j][1] = gr[128 * j + 1]; }
    for (int m0 = row_lo + 2 * gw; m0 < row_hi; m0 += 2 * NGW) {
        v4u hw[2][2]; f32x4 sq[2][4];
#pragma unroll
        for (int r = 0; r < 2; ++r) { const int m = m0 + r;
            const GAS v4u* hr = (const GAS v4u*)(h2base + (size_t)(m - row_lo) * D) + ln;
            hw[r][0] = hr[0]; hw[r][1] = hr[64];
            const f32x4* sp = (const f32x4*)(SS + (size_t)m * 16);
#pragma unroll
            for (int q = 0; q < 4; ++q) sq[r][q] = sp[q]; }
#pragma unroll
        for (int r = 0; r < 2; ++r) { const int m = m0 + r;
            GAS f32x4* xr = (GAS f32x4*)(outp + (size_t)m * D) + 2 * ln;
            const f32x4 s4 = (sq[r][0] + sq[r][1]) + (sq[r][2] + sq[r][3]);
            const float rstd = 1.0f / sqrtf(((s4[0] + s4[1]) + (s4[2] + s4[3])) * (1.0f / 1024.0f) + 1e-6f);
#pragma unroll
            for (int j = 0; j < 2; ++j) { const v4u w_ = hw[r][j];
                const f32x4 v0 = {bflo(w_[0]), bfhi(w_[0]), bflo(w_[1]), bfhi(w_[1])}, v1 = {bflo(w_[2]), bfhi(w_[2]), bflo(w_[3]), bfhi(w_[3])};
                __builtin_nontemporal_store(v0 * rstd * g[j][0], &xr[128 * j]); __builtin_nontemporal_store(v1 * rstd * g[j][1], &xr[128 * j + 1]); } }
    }
}

__device__ __forceinline__ void helper_barrier(gu32* cnt, const unsigned target) {
    asm volatile("s_waitcnt vmcnt(0)" ::: "memory");
    __syncthreads();
    if (threadIdx.x == 0) {
        __builtin_amdgcn_fence(__ATOMIC_RELEASE, "agent");
        asm volatile("s_waitcnt vmcnt(0)" ::: "memory");
        (void)__hip_atomic_fetch_add((unsigned*)cnt, 1u, __ATOMIC_RELAXED, __HIP_MEMORY_SCOPE_AGENT);
        unsigned sp = 0u;
        while (__hip_atomic_load((unsigned*)cnt, __ATOMIC_RELAXED, __HIP_MEMORY_SCOPE_AGENT) < target) { __builtin_amdgcn_s_sleep(2); if (++sp > (1u << 22)) break; }
        __builtin_amdgcn_fence(__ATOMIC_ACQUIRE, "agent");
        asm volatile("s_waitcnt vmcnt(0)" ::: "memory");
    }
    __syncthreads();
}
__device__ __forceinline__ void sample_tail(Frame& F) {
    const int hc = F.vcu - (F.G - N_HELP);
    helper_barrier(F.ctl + CW_HBAR, N_HELP);
    {   unsigned char* ws = KWS();
        pg8::Gemm g{(const pg8::bf16_t*)(ws + WS_MERGED) + (size_t)MP * D, (const pg8::bf16_t*)(ws + WS_WOUT), MS, D, D};
        pg8::StaticOrder S; S.init(MS, D, N_HELP, hc);
        pg8::EpiOut E{KIN(1), KIN(1), 1 << 30, KOUT() + (size_t)MP * D, (pg8::bf16_t*)(ws + WS_HBS), (float*)(ws + WS_SS2) + (size_t)MP * 16};
        pg8::gemm_phase<pg8::EpiOut, pg8::StaticOrder, true, true>(F.lds + RING_OFF, g, S, E);
    }
    helper_barrier(F.ctl + CW_HBAR + 64, N_HELP);
    {   unsigned char* ws = KWS();
        pg8::Gemm g{(const pg8::bf16_t*)(ws + WS_HBS), (const pg8::bf16_t*)(ws + WS_WGU), MS, NGU, D};
        pg8::StaticOrder S; S.init(MS, NGU, N_HELP, hc);
        pg8::EpiGU E{(const float*)(ws + WS_SS2) + (size_t)MP * 16, (pg8::bf16_t*)(ws + WS_ACTS), DFF, 0};
        pg8::gemm_phase<pg8::EpiGU, pg8::StaticOrder, true, true>(F.lds + RING_OFF, g, S, E);
    }
    helper_barrier(F.ctl + CW_HBAR + 128, N_HELP);
    {   unsigned char* ws = KWS();
        pg8::Gemm g{(const pg8::bf16_t*)(ws + WS_ACTS), (const pg8::bf16_t*)(ws + WS_WDN), MS, D, DFF};
        pg8::SplitKOrder S; S.init(MS, D, N_HELP, hc);
        pg8::EpiPart E{(float*)(ws + WS_PART), MS};
        pg8::gemm_phase<pg8::EpiPart, pg8::SplitKOrder, true, true>(F.lds + RING_OFF, g, S, E);
    }
    helper_barrier(F.ctl + CW_HBAR + 192, N_HELP);
    {   unsigned char* ws_ = KWS(); float* outp = KOUT();
        int ln = F.lane; asm volatile("" : "+v"(ln));
        const GAS f32x4* gr = (const GAS f32x4*)KIN(17) + 2 * ln;
        for (int m = hc * NWAVES + F.wave; m < MS; m += N_HELP * NWAVES) {
            const GAS v4u* hr = (const GAS v4u*)((const bf16*)(ws_ + WS_HBS) + (size_t)m * D) + ln;
            f32x4 v[2][2];
#pragma unroll
            for (int j = 0; j < 2; ++j) { const v4u w_ = hr[64 * j];
                v[j][0] = (f32x4){bflo(w_[0]), bfhi(w_[0]), bflo(w_[1]), bfhi(w_[1])}; v[j][1] = (f32x4){bflo(w_[2]), bfhi(w_[2]), bflo(w_[3]), bfhi(w_[3])}; }
#pragma unroll
            for (int q = 0; q < 4; ++q) { const GAS f32x4* pr = (const GAS f32x4*)((const float*)(ws_ + WS_PART) + ((size_t)q * MS + m) * D) + 2 * ln;
#pragma unroll
                for (int j = 0; j < 2; ++j) { v[j][0] += pr[128 * j]; v[j][1] += pr[128 * j + 1]; } }
            float ss = 0.f;
#pragma unroll
            for (int j = 0; j < 2; ++j) ss += pg8::dot4(v[j][0]) + pg8::dot4(v[j][1]);
            const float rstd = 1.0f / sqrtf(wave_sum(ss) * (1.0f / 1024.0f) + 1e-6f);
            GAS f32x4* xr = (GAS f32x4*)(outp + (size_t)(MP + m) * D) + 2 * ln;
#pragma unroll
            for (int j = 0; j < 2; ++j) { xr[128 * j] = v[j][0] * rstd * gr[128 * j]; xr[128 * j + 1] = v[j][1] * rstd * gr[128 * j + 1]; }
        }
    }
}

__device__ __forceinline__ int build_rstd_table(Frame& F, const pg8::StaticOrder& S, const float* SS) {
    LAS float* tab = (LAS float*)(F.lds + TAB_OFF); LAS int* tg = (LAS int*)(tab + 8 * 256);
    __syncthreads();
    if (F.tid < 8) tg[F.tid] = -1;
    __syncthreads();
    int n = 0, lastpm = -1;
    for (int i = 0; ; ++i) { pg8::Unit u; if (!S.next(i, u)) break;
        if (u.pm == lastpm) continue;
        if (n == 8) { n = 9; break; }
        if (F.tid < 256) { const f32x4* sp = (const f32x4*)(SS + (size_t)(u.pm * 256 + F.tid) * 16); const f32x4 s4 = (sp[0] + sp[1]) + (sp[2] + sp[3]);
            tab[n * 256 + F.tid] = __builtin_amdgcn_rsqf(((s4[0] + s4[1]) + (s4[2] + s4[3])) * (1.0f / 1024.0f) + pg8::RMS_EPS); }
        if (F.tid == 0) tg[n] = u.pm;
        ++n; lastpm = u.pm; }
    __syncthreads();
    return n <= 8 ? n : 0;
}

__global__ void __launch_bounds__(NWAVES * 64, 2) fwd_mega(Args args) {
    extern __shared__ __attribute__((aligned(16))) unsigned char lds[];
    Frame F;
    F.lds = (LAS unsigned char*)lds;
    F.MISC = (volatile LAS unsigned*)(F.lds + MISC_OFF);
    F.tid = threadIdx.x; F.lane = F.tid & 63; F.wave = __builtin_amdgcn_readfirstlane(F.tid >> 6);
    F.G = gridDim.x; { const int bx = blockIdx.x; F.vcu = (F.G % 8 == 0) ? (bx % 8) * (F.G / 8) + bx / 8 : bx; }
    F.ctl = (gu32*)(KWS() + WS_CTL);
    for (int u = F.tid; u < (LDS_BYTES - LDSCTL_OFF) / 4; u += NWAVES * 64) ((LAS unsigned*)(F.lds + LDSCTL_OFF))[u] = 0u;
    __syncthreads();
    XcdBarrier bar = xcd_barrier_post((unsigned*)(F.ctl + CW_BAR), F.MISC + 8);
#define GRID_BAR() xcd_barrier(bar)
    p0_prologue(F);
    GRID_BAR();
    {   unsigned char* ws = KWS();
        pg8::Gemm g{(const pg8::bf16_t*)(ws + WS_XN), (const pg8::bf16_t*)(ws + WS_WIN), MIN_ROWS, NIN, D};
        pg8::StaticOrder S; S.init(MIN_ROWS, NIN, F.G, (int)blockIdx.x);
        LAS float* gt = (LAS float*)(F.lds + TAB_OFF);
        { const f32x4 v = (F.tid < 256) ? ((const f32x4*)KIN(9))[F.tid] : ((const f32x4*)KIN(11))[F.tid - 256]; ((LAS f32x4*)gt)[F.tid] = v; }
        __syncthreads();
        pg8::EpiProj E{(pg8::bf16_t*)(ws + WS_PROJ), NPROJ, (float*)(ws + WS_ALR)};
        pg8::gemm_phase<pg8::EpiProj, pg8::StaticOrder, true, true>(F.lds + RING_OFF, g, S, E);
    }
    {
        const int nwg1 = (MIN_ROWS / 256) * (NIN / 256), rem = nwg1 % F.G, c = (int)blockIdx.x;
        const int ne = rem == 0 ? F.G : F.G - rem, e = rem == 0 ? c : c - rem;
        if (e >= 0) late_weight_items(F, e, ne);
    }
    GRID_BAR();
    const bool split = (F.G == 256);
    const int K0 = split ? 21 : 33;
    gla_prep_qk(F, 0, K0, true, F.wave * F.G + F.vcu, F.G * NWAVES);
    gla_prep_pool(F, 0, 4 * (K0 - 1), true, F.wave * (F.G >> 2) + (F.vcu >> 2), (F.G >> 2) * NWAVES);
    GRID_BAR();
    gla_scan(F, K0);
    if (split && F.vcu >= F.G - N_HELP) {
        const int hc = F.vcu - (F.G - N_HELP);
        gla_prep_qk(F, K0, 33, false, F.wave * N_HELP + hc, N_HELP * NWAVES);
        gla_prep_pool(F, 4 * (K0 - 1), 128, false, F.wave * (N_HELP >> 2) + (hc >> 2), (N_HELP >> 2) * NWAVES);
        asm volatile("s_waitcnt vmcnt(0)" ::: "memory");
        __syncthreads();
        if (F.tid == 0) { __builtin_amdgcn_fence(__ATOMIC_RELEASE, "agent"); asm volatile("s_waitcnt vmcnt(0)" ::: "memory"); (void)__hip_atomic_fetch_add((unsigned*)(F.ctl + CW_LATE), 1u, __ATOMIC_RELAXED, __HIP_MEMORY_SCOPE_AGENT); }
    }
    const int MROWS = (F.G == 256) ? MP : MO;
    if (F.G == 256 && F.vcu >= F.G - N_HELP) sample_tail(F);
    GRID_BAR();
    {   unsigned char* ws = KWS();
        pg8::Gemm g{(const pg8::bf16_t*)(ws + WS_MERGED), (const pg8::bf16_t*)(ws + WS_WOUT), MROWS, D, D};
        pg8::StaticOrder S; S.init(MROWS, D, F.G, (int)blockIdx.x);
        pg8::EpiOut E{KIN(0), KIN(1), MP, KOUT(), (pg8::bf16_t*)(ws + WS_HB), (float*)(ws + WS_SS2)};
        pg8::gemm_phase<pg8::EpiOut, pg8::StaticOrder, true, true>(F.lds + RING_OFF, g, S, E);
    }
    GRID_BAR();
    {   unsigned char* ws = KWS();
        pg8::Gemm g{(const pg8::bf16_t*)(ws + WS_HB), (const pg8::bf16_t*)(ws + WS_WGU), MROWS, NGU, D};
        pg8::StaticOrder S; S.init(MROWS, NGU, F.G, (int)blockIdx.x);
        const int ntab = build_rstd_table(F, S, (const float*)(ws + WS_SS2));
        pg8::EpiGU E{(const float*)(ws + WS_SS2), (pg8::bf16_t*)(ws + WS_ACT), DFF, ntab};
        pg8::gemm_phase<pg8::EpiGU, pg8::StaticOrder, true, true>(F.lds + RING_OFF, g, S, E);
    }
    GRID_BAR();
    {   unsigned char* ws = KWS();
        pg8::Gemm g{(const pg8::bf16_t*)(ws + WS_ACT), (const pg8::bf16_t*)(ws + WS_WDN), MROWS, D, DFF};
        pg8::StaticOrder S; S.init(MROWS, D, F.G, (int)blockIdx.x);
        pg8::EpiDown E{(float*)(ws + WS_SS3), (pg8::bf16_t*)(ws + WS_HB)};
        pg8::gemm_phase<pg8::EpiDown, pg8::StaticOrder, true, true>(F.lds + RING_OFF, g, S, E);
    }
    GRID_BAR();
    final_norm_phase(F, 0, MROWS, F.vcu * NWAVES + F.wave, F.G * NWAVES, (const bf16*)(KWS() + WS_HB));
}

extern "C" void kernel_launch(void* const* d_in, const int* in_sizes, int n_in, void* d_out, int out_size, void* d_ws, size_t ws_size, hipStream_t stream) {
    static int grid = 0;
    if (grid == 0) {
        if (n_in != 18 || ws_size < WS_END) { fprintf(stderr, "kernel_launch: needs 18 inputs and >= %zu bytes of workspace; got n_in %d, ws %zu; nothing launched\n", (size_t)WS_END, n_in, ws_size); grid = -1; return; }
        int dev = 0, cus = 0, per_cu = 0;
        if (hipGetDevice(&dev) != hipSuccess || hipDeviceGetAttribute(&cus, hipDeviceAttributeMultiprocessorCount, dev) != hipSuccess) { grid = -1; return; }
        if (hipFuncSetAttribute((const void*)fwd_mega, hipFuncAttributeMaxDynamicSharedMemorySize, LDS_BYTES) != hipSuccess) { fprintf(stderr, "kernel_launch: hipFuncSetAttribute failed\n"); grid = -1; return; }
        if (hipOccupancyMaxActiveBlocksPerMultiprocessor(&per_cu, (const void*)fwd_mega, NWAVES * 64, LDS_BYTES) != hipSuccess || per_cu < 1) { fprintf(stderr, "kernel_launch: occupancy query reports %d\n", per_cu); }
        (void)hipGetLastError();
        grid = cus;
    }
    if (grid < 0) return;
    if (hipMemsetAsync((char*)d_ws + WS_CTL, 0, CTL_ZERO_BYTES, stream) != hipSuccess) { fprintf(stderr, "kernel_launch: memset failed\n"); return; }
    Args a{};
    for (int i = 0; i < 18; ++i) a.in[i] = (const float*)d_in[i];
    a.out = (float*)d_out; a.ws = (unsigned char*)d_ws;
    hipLaunchKernelGGL(fwd_mega, dim3(grid), dim3(NWAVES * 64), LDS_BYTES, stream, a);
}
```
